# Optimizing an MI355X kernel written in HIP

```python
import math
import jax, jax.numpy as jnp
from jax import lax
import numpy as np

D_MODEL = 2048
BATCH = 8
SEQ = 2048
DEPTH = 1
DEC_BATCH = 16
DEC_SEQ = 32
PAST_LEN = 1024

CHUNK = 64
Q_BLOCK = 128
N_MEM = 256
EPS = 1e-6
NEG_INF = -1e30

GLA_HEADS = 4
GLA_DK = 128
GLA_DV = 256
GLA_GATE_RANK = 16
GLA_GATE_NORM = 16.0
DIFF_HEADS = 4
DIFF_DH = 64
DIFF_DV = 128
MEM_HEADS = 4
MEM_DH = 128
REL_BUCKETS = 32
REL_MAX_DIST = 128
D_FF = 5504

GLA_QK = GLA_HEADS * GLA_DK
GLA_V = GLA_HEADS * GLA_DV
DIFF_QK = DIFF_HEADS * 2 * DIFF_DH
DIFF_V = DIFF_HEADS * DIFF_DV
MEM_W = MEM_HEADS * MEM_DH
MIX_WIDTH = GLA_V + DIFF_V + MEM_W
SPLITS = (GLA_QK, GLA_QK, GLA_V, GLA_V, GLA_GATE_RANK, DIFF_QK, DIFF_QK, DIFF_V, MEM_W)
IN_WIDTH = GLA_QK * 2 + GLA_V * 2 + GLA_GATE_RANK + DIFF_QK * 2 + DIFF_V + MEM_W

kernel_name = 'hybrid_gla_diffattn_memory_macaron_step'


def rmsnorm(x, g):
    xf = x.astype(jnp.float32)
    y = xf * lax.rsqrt(jnp.mean(xf * xf, axis=-1, keepdims=True) + EPS)
    return (y * g.astype(jnp.float32)).astype(x.dtype)


def swiglu(x, w_in, w_out):
    gate, up = jnp.split(x @ w_in, 2, axis=-1)
    return (jax.nn.silu(gate) * up) @ w_out


def rel_bucket(rel):
    nb = REL_BUCKETS // 2
    max_exact = nb // 2
    ret = jnp.where(rel > 0, nb, 0)
    n = jnp.abs(rel)
    nf = jnp.maximum(n, 1).astype(jnp.float32)
    large = max_exact + (jnp.log(nf / max_exact) / math.log(REL_MAX_DIST / max_exact)
                         * (nb - max_exact)).astype(jnp.int32)
    large = jnp.minimum(large, nb - 1)
    return ret + jnp.where(n < max_exact, n, large)


def rel_bias(q_pos, k_pos, table):
    b = rel_bucket(k_pos[None, :] - q_pos[:, None])
    return jnp.transpose(table.astype(jnp.float32)[b], (2, 0, 1))


def project_groups(h, lp):
    B, T, _ = h.shape
    idx = np.cumsum(np.array(SPLITS))[:-1].tolist()
    gq, gk, gv, gr, glr, dq, dk, dv, mq = jnp.split(h @ lp['w_in'], idx, axis=-1)
    f32 = jnp.float32
    gq = gq.reshape(B, T, GLA_HEADS, GLA_DK).astype(f32) * (GLA_DK ** -0.5)
    gk = gk.reshape(B, T, GLA_HEADS, GLA_DK).astype(f32)
    gv = gv.reshape(B, T, GLA_HEADS, GLA_DV).astype(f32)
    gg = jax.nn.log_sigmoid((glr @ lp['w_gla_g2'] + lp['b_gla_g']).astype(f32)) / GLA_GATE_NORM
    gg = gg.reshape(B, T, GLA_HEADS, GLA_DK)
    dq = rmsnorm(dq.reshape(B, T, DIFF_HEADS, 2, DIFF_DH), lp['diff_q_norm'])
    dk = rmsnorm(dk.reshape(B, T, DIFF_HEADS, 2, DIFF_DH), lp['diff_k_norm'])
    dv = dv.reshape(B, T, DIFF_HEADS, DIFF_DV)
    mq = rmsnorm(mq.reshape(B, T, MEM_HEADS, MEM_DH), lp['mem_q_norm'])
    return gq, gk, gv, gr, gg, dq, dk, dv, mq


def gla_chunk(s0, q, k, v, g):
    b = jnp.cumsum(g, axis=2)
    qe = q * jnp.exp(b)
    ke = k * jnp.exp(-b)
    C = q.shape[2]
    causal = jnp.tril(jnp.ones((C, C), dtype=bool))
    a = jnp.where(causal, jnp.einsum('bhid,bhjd->bhij', qe, ke), 0.0)
    o = jnp.einsum('bhcd,bhde->bhce', qe, s0) + jnp.einsum('bhij,bhje->bhie', a, v)
    b_last = b[:, :, -1:, :]
    s1 = jnp.exp(b_last[:, :, 0, :, None]) * s0 + jnp.einsum('bhjd,bhje->bhde', k * jnp.exp(b_last - b), v)
    return s1, o


def diff_lambda_value(lam_params, layer):
    l = lam_params.astype(jnp.float32)
    lam_init = 0.8 - 0.6 * math.exp(-0.3 * layer)
    lam = jnp.exp(jnp.sum(l[0] * l[1])) - jnp.exp(jnp.sum(l[2] * l[3])) + lam_init
    return lam, lam_init


def diff_attend(q, k, v, q_pos, k_pos, lam, table):
    s = jnp.einsum('bqhcd,bkhcd->bhcqk', q.astype(jnp.float32), k.astype(jnp.float32)) * (DIFF_DH ** -0.5)
    s = s + rel_bias(q_pos, k_pos, table)[None, :, None]
    visible = (k_pos[None, :] // CHUNK) <= (q_pos[:, None] // CHUNK)
    p = jax.nn.softmax(jnp.where(visible, s, NEG_INF), axis=-1)
    a = p[:, :, 0] - lam * p[:, :, 1]
    return jnp.einsum('bhqk,bkhd->bqhd', a, v.astype(jnp.float32))


def mem_kv(mem, lp):
    B, M, _ = mem.shape
    k, v = jnp.split(rmsnorm(mem, lp['mem_norm']) @ lp['w_mem_kv'], 2, axis=-1)
    k = rmsnorm(k.reshape(B, M, MEM_HEADS, MEM_DH), lp['mem_k_norm'])
    return k, v.reshape(B, M, MEM_HEADS, MEM_DH)


def mem_attend(q, k, v):
    s = jnp.einsum('bqhd,bmhd->bhqm', q.astype(jnp.float32), k.astype(jnp.float32)) * (MEM_DH ** -0.5)
    p = jax.nn.softmax(s, axis=-1)
    return jnp.einsum('bhqm,bmhd->bqhd', p, v.astype(jnp.float32))


def merge(gla_o, gla_r, diff_o, mem_o, lam_init, lp, dtype):
    B, T = gla_o.shape[:2]
    g = rmsnorm(gla_o, lp['gla_out_norm']) * jax.nn.silu(gla_r.reshape(B, T, GLA_HEADS, GLA_DV).astype(jnp.float32))
    d = rmsnorm(diff_o, lp['diff_out_norm']) * (1.0 - lam_init)
    cat = jnp.concatenate([g.reshape(B, T, GLA_V), d.reshape(B, T, DIFF_V), mem_o.reshape(B, T, MEM_W)], axis=-1)
    return cat.astype(dtype) @ lp['w_o']


def mix_prompt(h, mem, lp, table, layer):
    B, S, _ = h.shape
    gq, gk, gv, gr, gg, dq, dk, dv, mq = project_groups(h, lp)
    n = S // CHUNK

    def to_chunks(t):
        return t.reshape(B, n, CHUNK, t.shape[2], t.shape[3]).transpose(1, 0, 3, 2, 4)

    s0 = jnp.zeros((B, GLA_HEADS, GLA_DK, GLA_DV), jnp.float32)
    gla_state, oc = lax.scan(lambda st, xs: gla_chunk(st, xs[0], xs[1], xs[2], xs[3]), s0,
                             (to_chunks(gq), to_chunks(gk), to_chunks(gv), to_chunks(gg)))
    gla_o = oc.transpose(1, 0, 3, 2, 4).reshape(B, S, GLA_HEADS, GLA_DV)
    lam, lam_init = diff_lambda_value(lp['diff_lambda'], layer)
    nb = S // Q_BLOCK
    k_pos = jnp.arange(S)
    q_blocks = dq.reshape(B, nb, Q_BLOCK, DIFF_HEADS, 2, DIFF_DH).swapaxes(0, 1)
    pos_blocks = k_pos.reshape(nb, Q_BLOCK)
    ob = lax.map(lambda xs: diff_attend(xs[0], dk, dv, xs[1], k_pos, lam, table), (q_blocks, pos_blocks))
    diff_o = ob.swapaxes(0, 1).reshape(B, S, DIFF_HEADS, DIFF_DV)
    mk, mv = mem_kv(mem, lp)
    mem_o = mem_attend(mq, mk, mv)
    y = merge(gla_o, gr, diff_o, mem_o, lam_init, lp, h.dtype)
    return y, (dk.reshape(B, S, DIFF_HEADS, 2 * DIFF_DH), dv, gla_state, mk, mv)


def mix_sample(h, past_k, past_v, gla_s0, mem_k, mem_v, lp, table, layer):
    B, T, _ = h.shape
    P = past_k.shape[1]
    gq, gk, gv, gr, gg, dq, dk, dv, mq = project_groups(h, lp)
    gla_state, o = gla_chunk(gla_s0.astype(jnp.float32), gq.transpose(0, 2, 1, 3), gk.transpose(0, 2, 1, 3),
                             gv.transpose(0, 2, 1, 3), gg.transpose(0, 2, 1, 3))
    gla_o = o.transpose(0, 2, 1, 3)
    lam, lam_init = diff_lambda_value(lp['diff_lambda'], layer)
    k_all = jnp.concatenate([past_k.reshape(B, P, DIFF_HEADS, 2, DIFF_DH).astype(dk.dtype), dk], axis=1)
    v_all = jnp.concatenate([past_v.astype(dv.dtype), dv], axis=1)
    q_pos = P + jnp.arange(T)
    k_pos = jnp.arange(P + T)
    diff_o = diff_attend(dq, k_all, v_all, q_pos, k_pos, lam, table)
    mem_o = mem_attend(mq, mem_k, mem_v)
    y = merge(gla_o, gr, diff_o, mem_o, lam_init, lp, h.dtype)
    return y, (dk.reshape(B, T, DIFF_HEADS, 2 * DIFF_DH), dv, gla_state)


def conformer_layer(x, mix, lp):
    x = x + 0.5 * swiglu(rmsnorm(x, lp['norm_ffn1']), lp['w_ffn1_in'], lp['w_ffn1_out'])
    y, state = mix(rmsnorm(x, lp['norm_mix']))
    x = x + y
    x = x + 0.5 * swiglu(rmsnorm(x, lp['norm_ffn2']), lp['w_ffn2_in'], lp['w_ffn2_out'])
    return rmsnorm(x, lp['norm_final']), state


def setup_inputs(seed: int = 0) -> dict:
    key = jax.random.key(seed)
    ks = list(jax.random.split(key, 32))
    f32 = jnp.float32

    def nrm(shape, scale):
        return jax.random.normal(ks.pop(), shape, f32) * scale

    def gain(shape):
        return 1.0 + nrm(shape, 0.02)

    D, L = D_MODEL, DEPTH
    return {
        'x_prompt': nrm((BATCH, SEQ, D), 1.0),
        'x_sample': nrm((DEC_BATCH, DEC_SEQ, D), 1.0),
        'mem_prompt': nrm((BATCH, N_MEM, D), 1.0),
        'cache_diff_k': nrm((L, DEC_BATCH, PAST_LEN, DIFF_HEADS, 2 * DIFF_DH), 1.0),
        'cache_diff_v': nrm((L, DEC_BATCH, PAST_LEN, DIFF_HEADS, DIFF_DV), 1.0),
        'state_gla': nrm((L, DEC_BATCH, GLA_HEADS, GLA_DK, GLA_DV), 0.5),
        'cache_mem_k': nrm((L, DEC_BATCH, N_MEM, MEM_HEADS, MEM_DH), 1.0),
        'cache_mem_v': nrm((L, DEC_BATCH, N_MEM, MEM_HEADS, MEM_DH), 1.0),
        'rel_bias_table': nrm((REL_BUCKETS, DIFF_HEADS), 0.5),
        'norm_ffn1': gain((L, D)),
        'w_ffn1_in': nrm((L, D, 2 * D_FF), D ** -0.5),
        'w_ffn1_out': nrm((L, D_FF, D), D_FF ** -0.5),
        'norm_mix': gain((L, D)),
        'w_in': nrm((L, D, IN_WIDTH), D ** -0.5),
        'w_gla_g2': nrm((L, GLA_GATE_RANK, GLA_QK), GLA_GATE_RANK ** -0.5),
        'b_gla_g': nrm((L, GLA_QK), 0.1),
        'gla_out_norm': gain((L, GLA_DV)),
        'diff_q_norm': gain((L, DIFF_DH)),
        'diff_k_norm': gain((L, DIFF_DH)),
        'diff_lambda': nrm((L, 4, DIFF_DH), 0.1),
        'diff_out_norm': gain((L, DIFF_DV)),
        'mem_norm': gain((L, D)),
        'w_mem_kv': nrm((L, D, 2 * MEM_W), D ** -0.5),
        'mem_q_norm': gain((L, MEM_DH)),
        'mem_k_norm': gain((L, MEM_DH)),
        'w_o': nrm((L, MIX_WIDTH, D), MIX_WIDTH ** -0.5),
        'norm_ffn2': gain((L, D)),
        'w_ffn2_in': nrm((L, D, 2 * D_FF), D ** -0.5),
        'w_ffn2_out': nrm((L, D_FF, D), D_FF ** -0.5),
        'norm_final': gain((L, D)),
    }


def reference(x_prompt, x_sample, mem_prompt, cache_diff_k, cache_diff_v, state_gla, cache_mem_k, cache_mem_v,
              rel_bias_table, norm_ffn1, w_ffn1_in, w_ffn1_out, norm_mix, w_in, w_gla_g2, b_gla_g, gla_out_norm,
              diff_q_norm, diff_k_norm, diff_lambda, diff_out_norm, mem_norm, w_mem_kv, mem_q_norm, mem_k_norm,
              w_o, norm_ffn2, w_ffn2_in, w_ffn2_out, norm_final):
    yp, ys = x_prompt, x_sample
    pk, pv, pg, pmk, pmv, sk, sv, sg = [], [], [], [], [], [], [], []
    for l in range(DEPTH):
        lp = {
            'norm_ffn1': norm_ffn1[l], 'w_ffn1_in': w_ffn1_in[l], 'w_ffn1_out': w_ffn1_out[l],
            'norm_mix': norm_mix[l], 'w_in': w_in[l], 'w_gla_g2': w_gla_g2[l], 'b_gla_g': b_gla_g[l],
            'gla_out_norm': gla_out_norm[l], 'diff_q_norm': diff_q_norm[l], 'diff_k_norm': diff_k_norm[l],
            'diff_lambda': diff_lambda[l], 'diff_out_norm': diff_out_norm[l], 'mem_norm': mem_norm[l],
            'w_mem_kv': w_mem_kv[l], 'mem_q_norm': mem_q_norm[l], 'mem_k_norm': mem_k_norm[l], 'w_o': w_o[l],
            'norm_ffn2': norm_ffn2[l], 'w_ffn2_in': w_ffn2_in[l], 'w_ffn2_out': w_ffn2_out[l],
            'norm_final': norm_final[l],
        }
        yp, (dk_p, dv_p, g_p, mk_p, mv_p) = conformer_layer(
            yp, lambda h: mix_prompt(h, mem_prompt, lp, rel_bias_table, l), lp)
        ys, (dk_s, dv_s, g_s) = conformer_layer(
            ys, lambda h: mix_sample(h, cache_diff_k[l], cache_diff_v[l], state_gla[l], cache_mem_k[l],
                                     cache_mem_v[l], lp, rel_bias_table, l), lp)
        pk.append(dk_p); pv.append(dv_p); pg.append(g_p); pmk.append(mk_p); pmv.append(mv_p)
        sk.append(dk_s); sv.append(dv_s); sg.append(g_s)
    return (yp, ys, jnp.stack(pk), jnp.stack(pv), jnp.stack(pg), jnp.stack(pmk), jnp.stack(pmv),
            jnp.stack(sk), jnp.stack(sv), jnp.stack(sg))
```

```cpp
#include <hip/hip_runtime.h>
#include <hip/hip_cooperative_groups.h>
#include <cstdio>
namespace cg = cooperative_groups;

#ifndef REP_PH
#define REP_PH -1
#endif
#ifndef MK_MULTI
#define MK_MULTI 0
#endif

#define LAS __attribute__((address_space(3)))
typedef unsigned short bf16_t;
typedef short bf16x8 __attribute__((ext_vector_type(8)));
typedef short bf16x4 __attribute__((ext_vector_type(4)));
typedef float f32x4 __attribute__((ext_vector_type(4)));
typedef unsigned u32x4 __attribute__((ext_vector_type(4)));
typedef unsigned u32x2 __attribute__((ext_vector_type(2)));

constexpr int TP = 16384, TT = 16896, DM = 2048, DFF = 5504, NFF = 11008, NIN = 5632;
constexpr float EPS = 1e-6f, LOG2E = 1.4426950408889634f;
constexpr size_t O_DKP = 34603008, O_DVP = O_DKP + 8388608, O_GSP = O_DVP + 8388608, O_MKP = O_GSP + 1048576, O_MVP = O_MKP + 1048576,
                 O_DKS = O_MVP + 1048576, O_DVS = O_DKS + 262144, O_GSS = O_DVS + 262144;
constexpr size_t WS_CTL = 0;
constexpr size_t WS_WFI = 16384;
constexpr size_t WS_WFO = WS_WFI + (size_t)NFF * DM * 2;
constexpr size_t WS_WIN = WS_WFO + (size_t)DM * DFF * 2;
constexpr size_t WS_WMEM = WS_WIN + (size_t)NIN * DM * 2;
constexpr size_t WS_WO = WS_WMEM + (size_t)1024 * DM * 2;
constexpr size_t WS_ABUF = WS_WO + (size_t)DM * DM * 2;
constexpr size_t WS_AMEM = WS_ABUF + (size_t)TT * DM * 2;
constexpr size_t WS_H = WS_AMEM + (size_t)2048 * DM * 2;
constexpr size_t WS_MKRAW = WS_H + (size_t)TT * DFF * 2;
constexpr size_t WS_KV = WS_MKRAW + (size_t)2048 * 512 * 4;
constexpr size_t WS_VTG = WS_KV + (size_t)2496 * 32768;
constexpr size_t WS_PART = WS_VTG;
constexpr size_t WS_WFI2 = WS_VTG + (size_t)1088 * 32768;
constexpr size_t WS_WFO2 = WS_WFI2 + (size_t)NFF * DM * 2;
constexpr size_t WS_END = WS_WFO2 + (size_t)DM * DFF * 2;
static_assert((size_t)8 * 512 * DM * 4 <= (size_t)1088 * 32768, "partials alias overflow");
constexpr size_t WS_GQ = WS_H;
constexpr size_t WS_GK = WS_GQ + (size_t)TT * 512 * 2;
constexpr size_t WS_GV = WS_GK + (size_t)TT * 512 * 2;
constexpr size_t WS_GR = WS_GV + (size_t)TT * 1024 * 2;
constexpr size_t WS_DQ = WS_GR + (size_t)TT * 1024 * 2;
constexpr size_t WS_MQ = WS_DQ + (size_t)TT * 512 * 2;
constexpr size_t WS_GG = WS_MQ + (size_t)TT * 512 * 2;
static_assert(WS_GG + (size_t)TT * 512 * 4 <= WS_MKRAW, "proj alias overflow");
constexpr size_t WS_QE = WS_WFI;
constexpr size_t WS_KE = WS_QE + (size_t)1088 * 16384;
constexpr size_t WS_KLT = WS_KE + (size_t)1088 * 16384;
constexpr size_t WS_EBL = WS_KLT + (size_t)1088 * 16384;
static_assert(WS_EBL + (size_t)1088 * 512 <= WS_WIN, "gla alias overflow");
constexpr int LDS_BYTES = 147456;

struct Params { const float* in[30]; float* out; unsigned char* ws; };

__device__ __forceinline__ unsigned pk2(float lo, float hi) { unsigned r; asm("v_cvt_pk_bf16_f32 %0, %1, %2" : "=v"(r) : "v"(lo), "v"(hi)); return r; }
__device__ __forceinline__ float bflo(unsigned u) { return __uint_as_float(u << 16); }
__device__ __forceinline__ float bfhi(unsigned u) { return __uint_as_float(u & 0xffff0000u); }
__device__ __forceinline__ float bf2f(bf16_t b) { return __uint_as_float(((unsigned)b) << 16); }
__device__ __forceinline__ float wave_sum(float v) {
#pragma unroll
    for (int o = 1; o < 64; o <<= 1) v += __shfl_xor(v, o);
    return v;
}
__device__ __forceinline__ float silu_f(float x) { return x * __builtin_amdgcn_rcpf(1.0f + __expf(-x)); }
__device__ __forceinline__ float logsigmoid_f(float x) { return fminf(x, 0.f) - __logf(1.0f + __expf(-fabsf(x))); }
#define LDSWAIT() asm volatile("s_waitcnt lgkmcnt(0)" ::: "memory")
#define BAR_LDS() do { asm volatile("s_waitcnt lgkmcnt(0)" ::: "memory"); __builtin_amdgcn_s_barrier(); asm volatile("" ::: "memory"); } while (0)
#define MFMA16(a, b, c) __builtin_amdgcn_mfma_f32_16x16x32_bf16((a), (b), (c), 0, 0, 0)

namespace pg8 {
constexpr int BM = 256, BK = 64, HALF = 128, HTB = HALF * BK * 2, STAGE_BYTES = 8 * HTB, NXCD = 8, WGM = 8;
__device__ __forceinline__ int lds_byte(int r, int c) { const int st = (r >> 4) * 2 + (c >> 5), rr = r & 15, cc = c & 31, ob = rr * 64 + cc * 2; return st * 1024 + (ob ^ (((ob >> 9) & 1) << 5)); }
__device__ __forceinline__ void stage_rc(int b, int& R, int& C) { const int st = b / 1024, sb = b % 1024, swz = sb ^ (((sb >> 9) & 1) << 5); R = (st >> 1) * 16 + swz / 64; C = (st & 1) * 32 + (swz % 64) / 2; }
__device__ __forceinline__ int perm32(int rho) { const int n = rho >> 4, i = rho & 15; return 8 * (i >> 2) + 4 * n + (i & 3); }

struct Unit { const char* a; const char* b; int pm, pn, gid, nt, atomic, part; };
struct GDesc { const bf16_t* A; const bf16_t* Bt; int nM, nN, mode; };
enum { EPI_SWIGLU = 0, EPI_RESX = 1, EPI_RESIN = 2, EPI_WIN = 3, EPI_MEMKV = 4 };

struct Sched {
    GDesc g0, g1; int n0, ntot, G, c, K, split;
    __device__ __forceinline__ bool next(int i, Unit& u) const {
        const long L = (long)i * G + c; if (L >= ntot) return false;
        if (split && L >= 512) {
            const int s = (int)L - 512, part = s & 7, P = K / 128, p0 = (P * part) >> 3, p1 = (P * (part + 1)) >> 3;
            u.pm = 64 + (s >> 6); u.pn = (s >> 3) & 7; u.gid = 0; u.nt = 2 * (p1 - p0); u.atomic = 1; u.part = part;
            u.a = (const char*)g0.A + (size_t)u.pm * 256 * K * 2 + (size_t)p0 * 256; u.b = (const char*)g0.Bt + (size_t)u.pn * 256 * K * 2 + (size_t)p0 * 256;
            return true;
        }
        const bool second = L >= n0; int wgid = second ? (int)L - n0 : (int)L;
        const int nM = second ? g1.nM : g0.nM, nN = second ? g1.nN : g0.nN, nwg = nM * nN;
        { const int q = nwg / NXCD, r = nwg % NXCD, xcd = wgid % NXCD, off = wgid / NXCD; wgid = (xcd < r ? xcd * (q + 1) : r * (q + 1) + (xcd - r) * q) + off; }
        const int nig = WGM * nN, gid = wgid / nig, fm = gid * WGM, gsz = (nM - fm) < WGM ? (nM - fm) : WGM;
        u.pm = fm + ((wgid % nig) % gsz); u.pn = (wgid % nig) / gsz; u.gid = second ? 1 : 0; u.nt = K / BK; u.atomic = 0; u.part = 0;
        const bf16_t* A = second ? g1.A : g0.A; const bf16_t* B = second ? g1.Bt : g0.Bt;
        u.a = (const char*)A + (size_t)u.pm * 256 * K * 2; u.b = (const char*)B + (size_t)u.pn * 256 * K * 2;
        return true;
    }
};

__device__ __forceinline__ void epilogue(const Params& p, int mode, int atomic, float alpha, const f32x4 (&acc)[2][2][4][2], int pm, int pn, int wr, int wc, int fr, int fq) {
    const int row0 = pm * 256 + wr * 64 + fr, cw = wc * 32 + fq * 8;
    if (mode == EPI_SWIGLU) {
        bf16_t* H = (bf16_t*)(p.ws + WS_H);
#pragma unroll
        for (int ai = 0; ai < 2; ++ai)
#pragma unroll
            for (int m = 0; m < 4; ++m) {
                const int row = row0 + ai * 128 + m * 16;
                const f32x4 g0 = acc[ai][0][m][0], g1 = acc[ai][0][m][1], u0 = acc[ai][1][m][0], u1 = acc[ai][1][m][1];
                u32x4 w;
                w.x = pk2(silu_f(g0[0]) * u0[0], silu_f(g0[1]) * u0[1]); w.y = pk2(silu_f(g0[2]) * u0[2], silu_f(g0[3]) * u0[3]);
                w.z = pk2(silu_f(g1[0]) * u1[0], silu_f(g1[1]) * u1[1]); w.w = pk2(silu_f(g1[2]) * u1[2], silu_f(g1[3]) * u1[3]);
                *(u32x4*)(H + (size_t)row * DFF + pn * 128 + cw) = w;
            }
    } else if ((mode == EPI_RESX || mode == EPI_RESIN) && atomic) {
        float* P = (float*)(p.ws + WS_PART) + (size_t)(atomic - 1) * 512 * DM;
#pragma unroll
        for (int ai = 0; ai < 2; ++ai)
#pragma unroll
            for (int m = 0; m < 4; ++m) {
                float* xr = P + (size_t)(row0 - TP + ai * 128 + m * 16) * DM + pn * 256 + cw;
#pragma unroll
                for (int bj = 0; bj < 2; ++bj) { *(f32x4*)(xr + bj * 128) = acc[ai][bj][m][0]; *(f32x4*)(xr + bj * 128 + 4) = acc[ai][bj][m][1]; }
            }
    } else if (mode == EPI_RESX || mode == EPI_RESIN) {
        float* X = p.out;
#pragma unroll
        for (int ai = 0; ai < 2; ++ai)
#pragma unroll
            for (int m = 0; m < 4; ++m) {
                const int row = row0 + ai * 128 + m * 16;
                const float* src = (mode == EPI_RESIN) ? (X + (size_t)row * DM) : (row < TP ? p.in[0] + (size_t)row * DM : p.in[1] + (size_t)(row - TP) * DM);
#pragma unroll
                for (int bj = 0; bj < 2; ++bj) {
                    const int col = pn * 256 + bj * 128 + cw;
                    const f32x4 s0 = *(const f32x4*)(src + col), s1 = *(const f32x4*)(src + col + 4);
                    *(f32x4*)(X + (size_t)row * DM + col) = s0 + alpha * acc[ai][bj][m][0];
                    *(f32x4*)(X + (size_t)row * DM + col + 4) = s1 + alpha * acc[ai][bj][m][1];
                }
            }
    } else if (mode == EPI_WIN) {
        if (pn < 14 || pn == 18 || pn == 19) {
            bf16_t* O; int ld, c0; float sc = 1.f;
            if (pn < 2) { O = (bf16_t*)(p.ws + WS_GQ); ld = 512; c0 = pn * 256; sc = 0.08838834764831845f; }
            else if (pn < 4) { O = (bf16_t*)(p.ws + WS_GK); ld = 512; c0 = (pn - 2) * 256; }
            else if (pn < 8) { O = (bf16_t*)(p.ws + WS_GV); ld = 1024; c0 = (pn - 4) * 256; }
            else if (pn < 12) { O = (bf16_t*)(p.ws + WS_GR); ld = 1024; c0 = (pn - 8) * 256; }
            else if (pn < 14) { O = (bf16_t*)(p.ws + WS_DQ); ld = 512; c0 = (pn - 12) * 256; }
            else { O = (bf16_t*)(p.ws + WS_MQ); ld = 512; c0 = (pn - 18) * 256; }
#pragma unroll
            for (int ai = 0; ai < 2; ++ai)
#pragma unroll
                for (int m = 0; m < 4; ++m) {
                    const int row = row0 + ai * 128 + m * 16;
#pragma unroll
                    for (int bj = 0; bj < 2; ++bj) {
                        const f32x4 v0 = acc[ai][bj][m][0] * sc, v1 = acc[ai][bj][m][1] * sc;
                        u32x4 w; w.x = pk2(v0[0], v0[1]); w.y = pk2(v0[2], v0[3]); w.z = pk2(v1[0], v1[1]); w.w = pk2(v1[2], v1[3]);
                        *(u32x4*)(O + (size_t)row * ld + c0 + bj * 128 + cw) = w;
                    }
                }
        } else if (pn < 18) {
            const bool isv = pn >= 16; const int c0 = (pn - (isv ? 16 : 14)) * 256;
#pragma unroll
            for (int ai = 0; ai < 2; ++ai)
#pragma unroll
                for (int m = 0; m < 4; ++m) {
                    const int row = row0 + ai * 128 + m * 16;
                    float* dst = row < TP ? p.out + (isv ? O_DVP : O_DKP) + (size_t)row * 512 : p.out + (isv ? O_DVS : O_DKS) + (size_t)(row - TP) * 512;
#pragma unroll
                    for (int bj = 0; bj < 2; ++bj) {
                        *(f32x4*)(dst + c0 + bj * 128 + cw) = acc[ai][bj][m][0];
                        *(f32x4*)(dst + c0 + bj * 128 + cw + 4) = acc[ai][bj][m][1];
                    }
                }
        } else {
            float* GG = (float*)(p.ws + WS_GG); const int c0 = (pn - 20) * 256; const float* bias = p.in[15];
#pragma unroll
            for (int bj = 0; bj < 2; ++bj) {
                const int col = c0 + bj * 128 + cw;
                const f32x4 b0 = *(const f32x4*)(bias + col), b1 = *(const f32x4*)(bias + col + 4);
#pragma unroll
                for (int ai = 0; ai < 2; ++ai)
#pragma unroll
                    for (int m = 0; m < 4; ++m) {
                        const int row = row0 + ai * 128 + m * 16;
                        f32x4 v0 = acc[ai][bj][m][0] + b0, v1 = acc[ai][bj][m][1] + b1;
#pragma unroll
                        for (int j = 0; j < 4; ++j) { v0[j] = logsigmoid_f(v0[j]) * 0.0625f; v1[j] = logsigmoid_f(v1[j]) * 0.0625f; }
                        *(f32x4*)(GG + (size_t)row * 512 + col) = v0; *(f32x4*)(GG + (size_t)row * 512 + col + 4) = v1;
                    }
            }
        }
    } else {
        const bool isv = pn >= 2; const int c0 = (pn - (isv ? 2 : 0)) * 256;
        float* dst = isv ? p.out + O_MVP : (float*)(p.ws + WS_MKRAW);
#pragma unroll
        for (int ai = 0; ai < 2; ++ai)
#pragma unroll
            for (int m = 0; m < 4; ++m) {
                const int row = row0 + ai * 128 + m * 16;
#pragma unroll
                for (int bj = 0; bj < 2; ++bj) {
                    *(f32x4*)(dst + (size_t)row * 512 + c0 + bj * 128 + cw) = acc[ai][bj][m][0];
                    *(f32x4*)(dst + (size_t)row * 512 + c0 + bj * 128 + cw + 4) = acc[ai][bj][m][1];
                }
            }
    }
}

__device__ __forceinline__ void gemm_phase(LAS unsigned char* lds, const Params& p, const Sched& S, float alpha, const int TIDX) {
    const int tid = TIDX, wid = __builtin_amdgcn_readfirstlane(tid >> 6), lane = tid & 63, wr = wid >> 2, wc = wid & 3, fr = lane & 15, fq = lane >> 4;
    const int K = S.K;
    unsigned voffA[2], voffB[2];
#pragma unroll
    for (int i = 0; i < 2; ++i) { int R, C; stage_rc(tid * 16 + i * 8192, R, C); const int Rb = (R & ~31) + perm32(R & 31);
        voffA[i] = (unsigned)(R * K + C) * 2u; voffB[i] = (unsigned)(Rb * K + C) * 2u; }
    const size_t kstep = (size_t)(BK * 2);
    const size_t hstep = (size_t)HALF * K * 2;
    const unsigned ldsw = (unsigned)wid * 1024u;
    const int aoff = lds_byte(wr * 64 + fr, fq * 8), boff = lds_byte(wc * 32 + fr, fq * 8);
#define PG8_SA(b, h) (((b) * 2 + (h)) * HTB)
#define PG8_SB(b, h) ((4 + (b) * 2 + (h)) * HTB)
#define PG8_STAGE(bufoff, gbase, voff) do { _Pragma("unroll") for (int _i = 0; _i < 2; ++_i) \
        __builtin_amdgcn_global_load_lds((const unsigned*)((const char*)(gbase) + (voff)[_i]), (LAS unsigned*)(lds + (bufoff) + ldsw + _i * 8192), 16, 0, 0); } while (0)
#define PG8_LDA(dst, b, h) do { _Pragma("unroll") for (int m = 0; m < 4; ++m) _Pragma("unroll") for (int k = 0; k < 2; ++k) dst[m][k] = *(const LAS bf16x8*)(lds + PG8_SA(b, h) + aoff + m * 2048 + k * 1024); } while (0)
#define PG8_LDB(dst, b, h) do { _Pragma("unroll") for (int n = 0; n < 2; ++n) _Pragma("unroll") for (int k = 0; k < 2; ++k) dst[n][k] = *(const LAS bf16x8*)(lds + PG8_SB(b, h) + boff + n * 2048 + k * 1024); } while (0)
#define PG8_MMA(ai, bj, At, Bt) do { __builtin_amdgcn_s_setprio(1); _Pragma("unroll") for (int m = 0; m < 4; ++m) _Pragma("unroll") for (int n = 0; n < 2; ++n) _Pragma("unroll") for (int k = 0; k < 2; ++k) \
        acc[ai][bj][m][n] = __builtin_amdgcn_mfma_f32_16x16x32_bf16(Bt[n][k], At[m][k], acc[ai][bj][m][n], 0, 0, 0); __builtin_amdgcn_s_setprio(0); } while (0)
#define PG8_WAIT_V(n) asm volatile("s_waitcnt vmcnt(" #n ")" ::: "memory")
#define PG8_WAIT_L(n) asm volatile("s_waitcnt lgkmcnt(" #n ")" ::: "memory")
#define PG8_BAR __builtin_amdgcn_s_barrier()
#define PG8_SCHED __builtin_amdgcn_sched_barrier(0)
    Unit cur, nxt; int ui = 0;
    if (!S.next(0, cur)) return;
    f32x4 acc[2][2][4][2];
#pragma unroll
    for (int a = 0; a < 2; ++a)
#pragma unroll
        for (int b = 0; b < 2; ++b)
#pragma unroll
            for (int m = 0; m < 4; ++m)
#pragma unroll
                for (int n = 0; n < 2; ++n) acc[a][b][m][n] = (f32x4){0.f, 0.f, 0.f, 0.f};
    bf16x8 At[4][2], B0[2][2], B1[2][2];
    const char* cA = cur.a; const char* cB = cur.b; int nt = cur.nt;
    PG8_STAGE(PG8_SB(0, 0), cB, voffB); PG8_STAGE(PG8_SA(0, 0), cA, voffA); PG8_STAGE(PG8_SB(0, 1), cB + hstep, voffB); PG8_STAGE(PG8_SA(0, 1), cA + hstep, voffA);
    if (wr == 1) PG8_BAR;
    PG8_WAIT_V(4); PG8_BAR;
    PG8_STAGE(PG8_SB(1, 0), cB + kstep, voffB); PG8_STAGE(PG8_SA(1, 0), cA + kstep, voffA); PG8_STAGE(PG8_SB(1, 1), cB + hstep + kstep, voffB);
    PG8_WAIT_V(6); PG8_BAR;
    for (;;) {
        const bool has_next = S.next(ui + 1, nxt);
        const char* nA = has_next ? nxt.a : cA; const char* nB = has_next ? nxt.b : cB;
        for (int t = 0; t < nt; t += 2) {
            const bool last = (t == nt - 2);
            const char* a1 = cA + (size_t)(t + 1) * kstep;
            const char* a2 = last ? nA : cA + (size_t)(t + 2) * kstep; const char* b2 = last ? nB : cB + (size_t)(t + 2) * kstep;
            const char* a3 = a2 + kstep; const char* b3 = b2 + kstep;
            PG8_LDB(B0, 0, 0); PG8_SCHED; PG8_LDA(At, 0, 0); PG8_STAGE(PG8_SA(1, 1), a1 + hstep, voffA);
            PG8_WAIT_L(8); PG8_BAR; PG8_WAIT_L(0); PG8_MMA(0, 0, At, B0); PG8_BAR; PG8_SCHED;
            PG8_LDB(B1, 0, 1); PG8_STAGE(PG8_SB(0, 0), b2, voffB);
            PG8_BAR; PG8_WAIT_L(0); PG8_MMA(0, 1, At, B1); PG8_BAR;
            PG8_LDA(At, 0, 1); PG8_STAGE(PG8_SA(0, 0), a2, voffA);
            PG8_BAR; PG8_WAIT_L(0); PG8_MMA(1, 0, At, B0); PG8_BAR; PG8_SCHED;
            PG8_STAGE(PG8_SB(0, 1), b2 + hstep, voffB);
            PG8_WAIT_V(6); PG8_BAR; PG8_MMA(1, 1, At, B1); PG8_BAR;
            PG8_LDB(B0, 1, 0); PG8_SCHED; PG8_LDA(At, 1, 0); PG8_STAGE(PG8_SA(0, 1), a2 + hstep, voffA);
            PG8_WAIT_L(8); PG8_BAR; PG8_WAIT_L(0); PG8_MMA(0, 0, At, B0); PG8_BAR; PG8_SCHED;
            PG8_LDB(B1, 1, 1); PG8_STAGE(PG8_SB(1, 0), b3, voffB);
            PG8_BAR; PG8_WAIT_L(0); PG8_MMA(0, 1, At, B1); PG8_BAR;
            PG8_LDA(At, 1, 1); PG8_STAGE(PG8_SA(1, 0), a3, voffA);
            PG8_BAR; PG8_WAIT_L(0); PG8_MMA(1, 0, At, B0); PG8_BAR; PG8_SCHED;
            PG8_STAGE(PG8_SB(1, 1), b3 + hstep, voffB);
            PG8_WAIT_V(6); PG8_BAR; PG8_MMA(1, 1, At, B1); PG8_BAR;
        }
        epilogue(p, cur.gid ? S.g1.mode : S.g0.mode, cur.atomic ? cur.part + 1 : 0, alpha, acc, cur.pm, cur.pn, wr, wc, fr, fq);
        if (!has_next) break;
#pragma unroll
        for (int a = 0; a < 2; ++a)
#pragma unroll
            for (int b = 0; b < 2; ++b)
#pragma unroll
                for (int m = 0; m < 4; ++m)
#pragma unroll
                    for (int n = 0; n < 2; ++n) acc[a][b][m][n] = (f32x4){0.f, 0.f, 0.f, 0.f};
        cur = nxt; cA = nA; cB = nB; nt = cur.nt; ++ui;
    }
    PG8_WAIT_V(0);
    if (wr == 0) PG8_BAR;
    PG8_BAR;
#undef PG8_SA
#undef PG8_SB
#undef PG8_STAGE
#undef PG8_LDA
#undef PG8_LDB
#undef PG8_MMA
#undef PG8_WAIT_V
#undef PG8_WAIT_L
#undef PG8_BAR
#undef PG8_SCHED
}
}

__device__ __forceinline__ void tr_matrix(const float* __restrict__ W, int K, int N, bf16_t* __restrict__ WT, int NBdst, int kind, const float* __restrict__ wg2,
                                          float* scr, int it0, int it1, int nw, int lane) {
    const int KB = K / 64, nitems = KB * NBdst; (void)KB;
    for (int it = it0; it < (it1 < nitems ? it1 : nitems); it += nw) {
        const int kb = it / NBdst, nb = it - kb * NBdst, k0 = kb * 64, n0 = nb * 32;
        int nsrc = n0;
        if (kind == 1) { const int pn = n0 >> 8, bj = (n0 >> 7) & 1, i = n0 & 127; nsrc = bj * DFF + pn * 128 + i; }
        else if (kind == 2) nsrc = n0 < 3072 ? n0 : n0 + 16;
        if (kind == 2 && n0 >= 5120) {
            const int n = lane & 31;
            float g2[16];
#pragma unroll
            for (int r = 0; r < 16; ++r) g2[r] = wg2[r * 512 + (n0 - 5120) + n];
#pragma unroll 4
            for (int i = 0; i < 32; ++i) {
                const int kk = 2 * i + (lane >> 5);
                const f32x4* wr = (const f32x4*)(W + (size_t)(k0 + kk) * N + 3072);
                const f32x4 a0 = wr[0], a1 = wr[1], a2 = wr[2], a3 = wr[3];
                float s = a0[0] * g2[0] + a0[1] * g2[1] + a0[2] * g2[2] + a0[3] * g2[3] + a1[0] * g2[4] + a1[1] * g2[5] + a1[2] * g2[6] + a1[3] * g2[7]
                        + a2[0] * g2[8] + a2[1] * g2[9] + a2[2] * g2[10] + a2[3] * g2[11] + a3[0] * g2[12] + a3[1] * g2[13] + a3[2] * g2[14] + a3[3] * g2[15];
                scr[kk * 33 + n] = s;
            }
        } else {
            float tv[32]; const float* wp = W + (size_t)(k0 + (lane >> 5)) * N + nsrc + (lane & 31);
#pragma unroll
            for (int i = 0; i < 32; ++i) tv[i] = wp[(size_t)(2 * i) * N];
#pragma unroll
            for (int i = 0; i < 32; ++i) scr[(2 * i + (lane >> 5)) * 33 + (lane & 31)] = tv[i];
        }
        LDSWAIT();
        const int c = lane & 7;
#pragma unroll
        for (int j = 0; j < 4; ++j) {
            const int n = (lane >> 3) + 8 * j; const float* s = scr + (8 * c) * 33 + n;
            u32x4 o; o.x = pk2(s[0], s[33]); o.y = pk2(s[66], s[99]); o.z = pk2(s[132], s[165]); o.w = pk2(s[198], s[231]);
            *(u32x4*)(WT + (size_t)(n0 + n) * K + k0 + 8 * c) = o;
        }
        LDSWAIT();
    }
}

__device__ __forceinline__ void norm_row_bf16(const float* __restrict__ x, const float* __restrict__ g, bf16_t* __restrict__ o, int lane) {
    f32x4 v[8]; float s = 0.f;
#pragma unroll
    for (int j = 0; j < 8; ++j) { v[j] = ((const f32x4*)x)[j * 64 + lane]; s += v[j][0] * v[j][0] + v[j][1] * v[j][1] + v[j][2] * v[j][2] + v[j][3] * v[j][3]; }
    s = wave_sum(s); const float rs = rsqrtf(s * (1.0f / DM) + EPS);
#pragma unroll
    for (int j = 0; j < 8; ++j) { const f32x4 gg = ((const f32x4*)g)[j * 64 + lane]; u32x2 w; w.x = pk2(v[j][0] * rs * gg[0], v[j][1] * rs * gg[1]); w.y = pk2(v[j][2] * rs * gg[2], v[j][3] * rs * gg[3]); ((u32x2*)o)[j * 64 + lane] = w; }
}

__device__ __forceinline__ void phase_prep0(const Params& p, unsigned char* sm, const int TIDX, const int BIDX) {
    const int tid = TIDX, wid = tid >> 6, lane = tid & 63, wgid = BIDX * 8 + wid, nw = gridDim.x * 8;
    float* scr = (float*)sm + wid * (64 * 33);
    if (BIDX == 0 && tid == 0) { ((unsigned*)(p.ws + WS_CTL))[0] = 0u; }
    for (int r = wgid; r < TT + 2048; r += nw) {
        if (r < TT) norm_row_bf16(r < TP ? p.in[0] + (size_t)r * DM : p.in[1] + (size_t)(r - TP) * DM, p.in[9], (bf16_t*)(p.ws + WS_ABUF) + (size_t)r * DM, lane);
        else norm_row_bf16(p.in[2] + (size_t)(r - TT) * DM, p.in[21], (bf16_t*)(p.ws + WS_AMEM) + (size_t)(r - TT) * DM, lane);
    }
    tr_matrix(p.in[10], DM, NFF, (bf16_t*)(p.ws + WS_WFI), NFF / 32, 1, nullptr, scr, wgid, 1 << 30, nw, lane);
    tr_matrix(p.in[22], DM, 1024, (bf16_t*)(p.ws + WS_WMEM), 1024 / 32, 0, nullptr, scr, wgid, 1 << 30, nw, lane);
}

__device__ __forceinline__ void load_row(const Params& p, int r, int mode, int lane, f32x4 (&v)[8]) {
    float* X = p.out;
    if (r < TP) {
#pragma unroll
        for (int j = 0; j < 8; ++j) v[j] = ((const f32x4*)(X + (size_t)r * DM))[j * 64 + lane];
    } else {
        const float* base = mode == 0 ? p.in[1] + (size_t)(r - TP) * DM : X + (size_t)r * DM;
        const float alpha = mode == 1 ? 1.0f : 0.5f;
        const float* P = (const float*)(p.ws + WS_PART) + (size_t)(r - TP) * DM;
#pragma unroll
        for (int j = 0; j < 8; ++j) {
            f32x4 a = (f32x4){0.f, 0.f, 0.f, 0.f};
#pragma unroll
            for (int q = 0; q < 8; ++q) a += ((const f32x4*)(P + (size_t)q * 512 * DM))[j * 64 + lane];
            v[j] = ((const f32x4*)base)[j * 64 + lane] + alpha * a;
            if (mode < 2) ((f32x4*)(X + (size_t)r * DM))[j * 64 + lane] = v[j];
        }
    }
}
__device__ __forceinline__ void phase_norm(const Params& p, unsigned char* sm, int mode, const int TIDX, const int BIDX) {
    const int tid = TIDX, wid = tid >> 6, lane = tid & 63, wgid = BIDX * 8 + wid, nw = gridDim.x * 8;
    float* X = p.out;
    const float* g = mode == 0 ? p.in[12] : (mode == 1 ? p.in[26] : p.in[29]);
    for (int r = wgid; r < TT; r += nw) {
        f32x4 v[8]; float s = 0.f;
        load_row(p, r, mode, lane, v);
#pragma unroll
        for (int j = 0; j < 8; ++j) s += v[j][0] * v[j][0] + v[j][1] * v[j][1] + v[j][2] * v[j][2] + v[j][3] * v[j][3];
        s = wave_sum(s); const float rs = rsqrtf(s * (1.0f / DM) + EPS);
        if (mode < 2) {
            bf16_t* o = (bf16_t*)(p.ws + WS_ABUF) + (size_t)r * DM;
#pragma unroll
            for (int j = 0; j < 8; ++j) { const f32x4 gg = ((const f32x4*)g)[j * 64 + lane]; u32x2 w; w.x = pk2(v[j][0] * rs * gg[0], v[j][1] * rs * gg[1]); w.y = pk2(v[j][2] * rs * gg[2], v[j][3] * rs * gg[3]); ((u32x2*)o)[j * 64 + lane] = w; }
        } else {
#pragma unroll
            for (int j = 0; j < 8; ++j) { const f32x4 gg = ((const f32x4*)g)[j * 64 + lane]; ((f32x4*)(X + (size_t)r * DM))[j * 64 + lane] = v[j] * rs * gg; }
        }
    }
}

__device__ __forceinline__ void unpack16(const u32x4 a, const u32x4 b, float (&f)[16]) {
    f[0] = bflo(a.x); f[1] = bfhi(a.x); f[2] = bflo(a.y); f[3] = bfhi(a.y); f[4] = bflo(a.z); f[5] = bfhi(a.z); f[6] = bflo(a.w); f[7] = bfhi(a.w);
    f[8] = bflo(b.x); f[9] = bfhi(b.x); f[10] = bflo(b.y); f[11] = bfhi(b.y); f[12] = bflo(b.z); f[13] = bfhi(b.z); f[14] = bflo(b.w); f[15] = bfhi(b.w);
}

__device__ __forceinline__ void phase_post(const Params& p, unsigned char* sm, const int TIDX, const int BIDX) {
    const int tid = TIDX, wid = tid >> 6, lane = tid & 63, wgid = BIDX * 8 + wid, nw = gridDim.x * 8;
    {
        bf16_t* DQ = (bf16_t*)(p.ws + WS_DQ); bf16_t* MQ = (bf16_t*)(p.ws + WS_MQ);
        const float* gq = p.in[17]; const float* gm = p.in[23];
        float g1[8], g2[8];
#pragma unroll
        for (int i = 0; i < 8; ++i) { g1[i] = gq[(8 * lane + i) & 63]; g2[i] = gm[(8 * lane + i) & 127]; }
        for (int t = wgid; t < TT; t += nw) {
            u32x4 a = *(const u32x4*)(DQ + (size_t)t * 512 + 8 * lane);
            u32x4 b = *(const u32x4*)(MQ + (size_t)t * 512 + 8 * lane);
            float x[8] = {bflo(a.x), bfhi(a.x), bflo(a.y), bfhi(a.y), bflo(a.z), bfhi(a.z), bflo(a.w), bfhi(a.w)};
            float y[8] = {bflo(b.x), bfhi(b.x), bflo(b.y), bfhi(b.y), bflo(b.z), bfhi(b.z), bflo(b.w), bfhi(b.w)};
            float s1 = 0.f, s2 = 0.f;
#pragma unroll
            for (int i = 0; i < 8; ++i) { s1 += x[i] * x[i]; s2 += y[i] * y[i]; }
            s1 += __shfl_xor(s1, 1); s1 += __shfl_xor(s1, 2); s1 += __shfl_xor(s1, 4);
            s2 += __shfl_xor(s2, 1); s2 += __shfl_xor(s2, 2); s2 += __shfl_xor(s2, 4); s2 += __shfl_xor(s2, 8);
            const float r1 = rsqrtf(s1 * (1.0f / 64) + EPS), r2 = rsqrtf(s2 * (1.0f / 128) + EPS);
            u32x4 oa, ob;
            oa.x = pk2(x[0] * r1 * g1[0], x[1] * r1 * g1[1]); oa.y = pk2(x[2] * r1 * g1[2], x[3] * r1 * g1[3]); oa.z = pk2(x[4] * r1 * g1[4], x[5] * r1 * g1[5]); oa.w = pk2(x[6] * r1 * g1[6], x[7] * r1 * g1[7]);
            ob.x = pk2(y[0] * r2 * g2[0], y[1] * r2 * g2[1]); ob.y = pk2(y[2] * r2 * g2[2], y[3] * r2 * g2[3]); ob.z = pk2(y[4] * r2 * g2[4], y[5] * r2 * g2[5]); ob.w = pk2(y[6] * r2 * g2[6], y[7] * r2 * g2[7]);
            *(u32x4*)(DQ + (size_t)t * 512 + 8 * lane) = oa; *(u32x4*)(MQ + (size_t)t * 512 + 8 * lane) = ob;
        }
    }
    const int r = tid >> 3, cseg = tid & 7;
    for (int id = BIDX; id < 2496; id += gridDim.x) {
        const float* ksrc; const float* vsrc; float* kdst = nullptr; const float* gain = nullptr; int G = 0, nvalid = 64;
        if (id < 1024) { const int bh = id >> 5, tile = id & 31, b = bh >> 2, h = bh & 3; const size_t o = ((size_t)(b * 2048 + tile * 64)) * 512 + h * 128;
            ksrc = p.out + O_DKP + o; kdst = p.out + O_DKP + o; vsrc = p.out + O_DVP + o; G = 64; gain = p.in[18]; }
        else if (id < 2112) { const int q = id - 1024, sbh = q / 17, tile = q - sbh * 17, sb = sbh >> 2, h = sbh & 3;
            if (tile < 16) { const size_t o = ((size_t)(sb * 1024 + tile * 64)) * 512 + h * 128; ksrc = p.in[3] + o; vsrc = p.in[4] + o; }
            else { const size_t o = ((size_t)(sb * 32)) * 512 + h * 128; ksrc = p.out + O_DKS + o; kdst = p.out + O_DKS + o; vsrc = p.out + O_DVS + o; G = 64; gain = p.in[18]; nvalid = 32; } }
        else if (id < 2240) { const int q = id - 2112, bh = q >> 2, tile = q & 3, b = bh >> 2, h = bh & 3; const size_t o = ((size_t)(b * 256 + tile * 64)) * 512 + h * 128;
            ksrc = (const float*)(p.ws + WS_MKRAW) + o; kdst = p.out + O_MKP + o; vsrc = p.out + O_MVP + o; G = 128; gain = p.in[24]; }
        else { const int q = id - 2240, sbh = q >> 2, tile = q & 3, sb = sbh >> 2, h = sbh & 3; const size_t o = ((size_t)(sb * 256 + tile * 64)) * 512 + h * 128;
            ksrc = p.in[6] + o; vsrc = p.in[7] + o; }
        bf16_t* Kt = (bf16_t*)(p.ws + WS_KV + (size_t)id * 32768); bf16_t* Vt = Kt + 8192;
        const bool ok = r < nvalid;
        f32x4 k4[4], v4[4];
#pragma unroll
        for (int i = 0; i < 4; ++i) {
            k4[i] = ok ? *(const f32x4*)(ksrc + (size_t)r * 512 + cseg * 16 + i * 4) : (f32x4){0.f, 0.f, 0.f, 0.f};
            v4[i] = ok ? *(const f32x4*)(vsrc + (size_t)r * 512 + cseg * 16 + i * 4) : (f32x4){0.f, 0.f, 0.f, 0.f};
        }
        if (G) {
            float s = 0.f;
#pragma unroll
            for (int i = 0; i < 4; ++i) s += k4[i][0] * k4[i][0] + k4[i][1] * k4[i][1] + k4[i][2] * k4[i][2] + k4[i][3] * k4[i][3];
            s += __shfl_xor(s, 1); s += __shfl_xor(s, 2); if (G == 128) s += __shfl_xor(s, 4);
            const float rs = rsqrtf(s / (float)G + EPS);
#pragma unroll
            for (int i = 0; i < 4; ++i) { const f32x4 gg = *(const f32x4*)(gain + ((cseg * 16 + i * 4) & (G - 1))); k4[i] = k4[i] * rs * gg; }
            if (ok) {
#pragma unroll
                for (int i = 0; i < 4; ++i) *(f32x4*)(kdst + (size_t)r * 512 + cseg * 16 + i * 4) = k4[i];
            }
        }
        { u32x4 w0, w1; w0.x = pk2(k4[0][0], k4[0][1]); w0.y = pk2(k4[0][2], k4[0][3]); w0.z = pk2(k4[1][0], k4[1][1]); w0.w = pk2(k4[1][2], k4[1][3]);
          w1.x = pk2(k4[2][0], k4[2][1]); w1.y = pk2(k4[2][2], k4[2][3]); w1.z = pk2(k4[3][0], k4[3][1]); w1.w = pk2(k4[3][2], k4[3][3]);
          *(u32x4*)(Kt + r * 128 + cseg * 16) = w0; *(u32x4*)(Kt + r * 128 + cseg * 16 + 8) = w1; }
        bf16_t* T = (bf16_t*)sm;
        __syncthreads();
#pragma unroll
        for (int i = 0; i < 4; ++i)
#pragma unroll
            for (int j = 0; j < 4; ++j) T[(cseg * 16 + i * 4 + j) * 72 + r] = (bf16_t)(pk2(v4[i][j], 0.f) & 0xffffu);
        __syncthreads();
        { const int col = tid >> 2, seg = tid & 3; const u32x4 a = *(const u32x4*)(T + col * 72 + seg * 16), b = *(const u32x4*)(T + col * 72 + seg * 16 + 8);
          *(u32x4*)(Vt + col * 64 + seg * 16) = a; *(u32x4*)(Vt + col * 64 + seg * 16 + 8) = b; }
    }
    float* Gs = (float*)sm;
    float* SEG = (float*)(sm + 33792);
    bf16_t* TTb = (bf16_t*)(sm + 35840);
    bf16_t* VV = (bf16_t*)(sm + 54272);
    for (int job = BIDX; job < 1088; job += gridDim.x) {
        const int c = job >> 2, h = job & 3;
        const int t0 = c < 256 ? c * 64 : TP + (c - 256) * 32, nvalid = c < 256 ? 64 : 32;
        const bool ok = r < nvalid;
        __syncthreads();
        {
            const float* gg = (const float*)(p.ws + WS_GG) + (size_t)(t0 + r) * 512 + h * 128 + cseg * 16;
#pragma unroll
            for (int i = 0; i < 4; ++i) { float z = 0.f; asm volatile("" : "+v"(z)); f32x4 v = (f32x4){z, z, z, z}; if (ok) v = *(const f32x4*)(gg + i * 4); *(f32x4*)(Gs + r * 132 + cseg * 16 + i * 4) = v; }
        }
        __syncthreads();
        { const int seg = tid >> 7, d = tid & 127; float s = 0.f;
#pragma unroll
          for (int i = 0; i < 16; ++i) s += Gs[(seg * 16 + i) * 132 + d];
          SEG[seg * 128 + d] = s;
          __syncthreads();
          float run = 0.f;
          for (int s2 = 0; s2 < seg; ++s2) run += SEG[s2 * 128 + d];
#pragma unroll
          for (int i = 0; i < 16; ++i) { run += Gs[(seg * 16 + i) * 132 + d]; Gs[(seg * 16 + i) * 132 + d] = run; }
        }
        __syncthreads();
        {
            float q[16], k[16];
            if (ok) {
                const bf16_t* gq = (const bf16_t*)(p.ws + WS_GQ) + (size_t)(t0 + r) * 512 + h * 128 + cseg * 16;
                const bf16_t* gk = (const bf16_t*)(p.ws + WS_GK) + (size_t)(t0 + r) * 512 + h * 128 + cseg * 16;
                unpack16(*(const u32x4*)gq, *(const u32x4*)(gq + 8), q); unpack16(*(const u32x4*)gk, *(const u32x4*)(gk + 8), k);
            } else {
#pragma unroll
                for (int i = 0; i < 16; ++i) { q[i] = 0.f; k[i] = 0.f; }
            }
            float qe[16], ke[16];
#pragma unroll
            for (int i = 0; i < 16; ++i) {
                const float b = Gs[r * 132 + cseg * 16 + i], bl = Gs[63 * 132 + cseg * 16 + i];
                qe[i] = q[i] * __expf(b); ke[i] = k[i] * __expf(-b);
                TTb[(cseg * 16 + i) * 72 + r] = (bf16_t)(pk2(k[i] * __expf(bl - b), 0.f) & 0xffffu);
                if (r == 63) ((float*)(p.ws + WS_EBL))[job * 128 + cseg * 16 + i] = __expf(bl);
            }
            bf16_t* QE = (bf16_t*)(p.ws + WS_QE) + (size_t)job * 8192 + r * 128 + cseg * 16;
            bf16_t* KE = (bf16_t*)(p.ws + WS_KE) + (size_t)job * 8192 + r * 128 + cseg * 16;
            u32x4 w0, w1;
            w0.x = pk2(qe[0], qe[1]); w0.y = pk2(qe[2], qe[3]); w0.z = pk2(qe[4], qe[5]); w0.w = pk2(qe[6], qe[7]);
            w1.x = pk2(qe[8], qe[9]); w1.y = pk2(qe[10], qe[11]); w1.z = pk2(qe[12], qe[13]); w1.w = pk2(qe[14], qe[15]);
            *(u32x4*)QE = w0; *(u32x4*)(QE + 8) = w1;
            w0.x = pk2(ke[0], ke[1]); w0.y = pk2(ke[2], ke[3]); w0.z = pk2(ke[4], ke[5]); w0.w = pk2(ke[6], ke[7]);
            w1.x = pk2(ke[8], ke[9]); w1.y = pk2(ke[10], ke[11]); w1.z = pk2(ke[12], ke[13]); w1.w = pk2(ke[14], ke[15]);
            *(u32x4*)KE = w0; *(u32x4*)(KE + 8) = w1;
        }
        {
            const bf16_t* gv = (const bf16_t*)(p.ws + WS_GV) + (size_t)(t0 + r) * 1024 + h * 256 + cseg * 32;
#pragma unroll
            for (int i = 0; i < 4; ++i) {
                const u32x4 a = ok ? *(const u32x4*)(gv + i * 8) : (u32x4){0u, 0u, 0u, 0u};
                const int e = cseg * 32 + i * 8;
                VV[(e + 0) * 72 + r] = (bf16_t)(a.x & 0xffffu); VV[(e + 1) * 72 + r] = (bf16_t)(a.x >> 16);
                VV[(e + 2) * 72 + r] = (bf16_t)(a.y & 0xffffu); VV[(e + 3) * 72 + r] = (bf16_t)(a.y >> 16);
                VV[(e + 4) * 72 + r] = (bf16_t)(a.z & 0xffffu); VV[(e + 5) * 72 + r] = (bf16_t)(a.z >> 16);
                VV[(e + 6) * 72 + r] = (bf16_t)(a.w & 0xffffu); VV[(e + 7) * 72 + r] = (bf16_t)(a.w >> 16);
            }
        }
        __syncthreads();
        { const int d = tid >> 2, seg = tid & 3; bf16_t* KLT = (bf16_t*)(p.ws + WS_KLT) + (size_t)job * 8192 + d * 64 + seg * 16;
          *(u32x4*)KLT = *(const u32x4*)(TTb + d * 72 + seg * 16); *(u32x4*)(KLT + 8) = *(const u32x4*)(TTb + d * 72 + seg * 16 + 8); }
        { const int e = tid >> 1, seg = tid & 1; bf16_t* VT = (bf16_t*)(p.ws + WS_VTG) + (size_t)job * 16384 + e * 64 + seg * 32;
#pragma unroll
          for (int i = 0; i < 4; ++i) *(u32x4*)(VT + i * 8) = *(const u32x4*)(VV + e * 72 + seg * 32 + i * 8); }
    }
}

__device__ __forceinline__ void conv_item(const Params& p, unsigned char* sm, int list, int j, const int TIDX) {
    const int wid = TIDX >> 6, lane = TIDX & 63; float* scr = (float*)sm + wid * (64 * 33);
    if (list == 0) {
        if (j < 86) tr_matrix(p.in[11], DFF, DM, (bf16_t*)(p.ws + WS_WFO), DM / 32, 0, nullptr, scr, j * 64 + wid, j * 64 + 64, 8, lane);
        else if (j < 174) tr_matrix(p.in[13], DM, 5136, (bf16_t*)(p.ws + WS_WIN), NIN / 32, 2, p.in[14], scr, (j - 86) * 64 + wid, (j - 86) * 64 + 64, 8, lane);
        else tr_matrix(p.in[25], DM, DM, (bf16_t*)(p.ws + WS_WO), DM / 32, 0, nullptr, scr, (j - 174) * 64 + wid, (j - 174) * 64 + 64, 8, lane);
    } else {
        if (j < 172) tr_matrix(p.in[27], DM, NFF, (bf16_t*)(p.ws + WS_WFI2), NFF / 32, 1, nullptr, scr, j * 64 + wid, j * 64 + 64, 8, lane);
        else tr_matrix(p.in[28], DFF, DM, (bf16_t*)(p.ws + WS_WFO2), DM / 32, 0, nullptr, scr, (j - 172) * 64 + wid, (j - 172) * 64 + 64, 8, lane);
    }
}
__device__ __forceinline__ void conv_queue(const Params& p, unsigned char* sm, int list, int nitems, unsigned* ctr, const int TIDX) {
    int* sitem = (int*)(sm + LDS_BYTES - 16);
    for (;;) {
        __syncthreads();
        if (TIDX == 0) *sitem = (int)atomicAdd(ctr, 1u);
        __syncthreads();
        const int j = __builtin_amdgcn_readfirstlane(*sitem);
        if (j >= nitems) break;
        int tl = TIDX; asm volatile("" : "+v"(tl));
        conv_item(p, sm, list, j, tl);
    }
}

__device__ __forceinline__ void gla_item(const Params& p, unsigned char* sm, int h, int job0, int jobstride, int nchunks, int tok0, int nvalid, const float* s_init, float* s_out, const int TIDX) {
    const int tid = TIDX, w = __builtin_amdgcn_readfirstlane(tid >> 6), lane = tid & 63, r16 = lane & 15, g = lane >> 4;
    unsigned char* QEl = sm; unsigned char* KEl = sm + 17408; unsigned char* KLl = sm + 34816; unsigned char* VTl = sm + 53248; unsigned char* AMl = sm + 90112;
    float* EBl = (float*)(sm + 99328); float* SSQ = (float*)(sm + 99840); float* RSl = (float*)(sm + 101888); unsigned char* OTl = sm + 102400;
    const bf16_t* QEg = (const bf16_t*)(p.ws + WS_QE); const bf16_t* KEg = (const bf16_t*)(p.ws + WS_KE); const bf16_t* KLg = (const bf16_t*)(p.ws + WS_KLT);
    const bf16_t* VTg = (const bf16_t*)(p.ws + WS_VTG); const float* EBg = (const float*)(p.ws + WS_EBL); const bf16_t* GRg = (const bf16_t*)(p.ws + WS_GR);
    bf16_t* CAT = (bf16_t*)(p.ws + WS_ABUF);
    f32x4 S[8][2];
#pragma unroll
    for (int db = 0; db < 8; ++db) { S[db][0] = (f32x4){0.f, 0.f, 0.f, 0.f}; S[db][1] = (f32x4){0.f, 0.f, 0.f, 0.f}; }
    if (s_init) {
        const float* sp = s_init + (size_t)(4 * g) * 256 + 32 * w + r16;
#pragma unroll
        for (int db = 0; db < 8; ++db) {
#pragma unroll
            for (int j = 0; j < 4; ++j) { S[db][0][j] = sp[j * 256]; S[db][1][j] = sp[j * 256 + 16]; }
            sp += 16 * 256; asm volatile("" : "+v"(sp));
        }
    }
    u32x4 pq[2], pk[2], pl[2], pv[4]; f32x4 pe;
#define GLA_LOAD(job, t0) do { \
        _Pragma("unroll") for (int k_ = 0; k_ < 2; ++k_) { const int id_ = tid + 512 * k_; pq[k_] = *(const u32x4*)(QEg + (size_t)(job) * 8192 + id_ * 8); pk[k_] = *(const u32x4*)(KEg + (size_t)(job) * 8192 + id_ * 8); pl[k_] = *(const u32x4*)(KLg + (size_t)(job) * 8192 + id_ * 8); } \
        _Pragma("unroll") for (int k_ = 0; k_ < 4; ++k_) { const int id_ = tid + 512 * k_; pv[k_] = *(const u32x4*)(VTg + (size_t)(job) * 16384 + id_ * 8); } \
        pe = tid < 32 ? *(const f32x4*)(EBg + (size_t)(job) * 128 + tid * 4) : (f32x4){0.f, 0.f, 0.f, 0.f}; } while (0)
#define GLA_STORE() do { \
        _Pragma("unroll") for (int k_ = 0; k_ < 2; ++k_) { const int id_ = tid + 512 * k_; *(u32x4*)(QEl + (id_ >> 4) * 272 + (id_ & 15) * 16) = pq[k_]; *(u32x4*)(KEl + (id_ >> 4) * 272 + (id_ & 15) * 16) = pk[k_]; *(u32x4*)(KLl + (id_ >> 3) * 144 + (id_ & 7) * 16) = pl[k_]; } \
        _Pragma("unroll") for (int k_ = 0; k_ < 4; ++k_) { const int id_ = tid + 512 * k_; *(u32x4*)(VTl + (id_ >> 3) * 144 + (id_ & 7) * 16) = pv[k_]; } \
        if (tid < 32) *(f32x4*)(EBl + tid * 4) = pe; } while (0)
    BAR_LDS();
    GLA_LOAD(job0, tok0);
    GLA_STORE();
    BAR_LDS();
    for (int ci = 0; ci < nchunks; ++ci) {
        const int t0 = tok0 + ci * 64;
        {
            const int ib = w >> 1;
#pragma unroll
            for (int jbi = 0; jbi < 2; ++jbi) {
                const int jb = 2 * (w & 1) + jbi; f32x4 acc = (f32x4){0.f, 0.f, 0.f, 0.f};
#pragma unroll
                for (int ks = 0; ks < 4; ++ks) {
                    const bf16x8 A = *(const bf16x8*)(QEl + (16 * ib + r16) * 272 + (32 * ks + 8 * g) * 2);
                    const bf16x8 B = *(const bf16x8*)(KEl + (16 * jb + r16) * 272 + (32 * ks + 8 * g) * 2);
                    acc = MFMA16(A, B, acc);
                }
#pragma unroll
                for (int j = 0; j < 4; ++j) { const int i = 16 * ib + 4 * g + j, jj = 16 * jb + r16; const float v = jj <= i ? acc[j] : 0.f;
                    *(bf16_t*)(AMl + i * 144 + jj * 2) = (bf16_t)(pk2(v, 0.f) & 0xffffu); }
            }
        }
        f32x4 o[4][2];
#pragma unroll
        for (int ib = 0; ib < 4; ++ib) { o[ib][0] = (f32x4){0.f, 0.f, 0.f, 0.f}; o[ib][1] = (f32x4){0.f, 0.f, 0.f, 0.f}; }
#pragma unroll
        for (int ks = 0; ks < 4; ++ks) {
            bf16x8 Sf[2];
#pragma unroll
            for (int eb = 0; eb < 2; ++eb) {
                u32x4 t; t.x = pk2(S[2 * ks][eb][0], S[2 * ks][eb][1]); t.y = pk2(S[2 * ks][eb][2], S[2 * ks][eb][3]);
                t.z = pk2(S[2 * ks + 1][eb][0], S[2 * ks + 1][eb][1]); t.w = pk2(S[2 * ks + 1][eb][2], S[2 * ks + 1][eb][3]);
                Sf[eb] = __builtin_bit_cast(bf16x8, t);
            }
#pragma unroll
            for (int ib = 0; ib < 4; ++ib) {
                const u32x2 a0 = *(const u32x2*)(QEl + (16 * ib + r16) * 272 + (32 * ks + 4 * g) * 2);
                const u32x2 a1 = *(const u32x2*)(QEl + (16 * ib + r16) * 272 + (32 * ks + 16 + 4 * g) * 2);
                const bf16x8 A = __builtin_bit_cast(bf16x8, ((u32x4){a0.x, a0.y, a1.x, a1.y}));
                o[ib][0] = MFMA16(A, Sf[0], o[ib][0]); o[ib][1] = MFMA16(A, Sf[1], o[ib][1]);
            }
        }
        bf16x8 Vf[2][2];
#pragma unroll
        for (int ks = 0; ks < 2; ++ks)
#pragma unroll
            for (int eb = 0; eb < 2; ++eb) Vf[ks][eb] = *(const bf16x8*)(VTl + (32 * w + 16 * eb + r16) * 144 + (32 * ks + 8 * g) * 2);
#pragma unroll
        for (int db = 0; db < 8; ++db) {
            const f32x4 e4 = *(const f32x4*)(EBl + 16 * db + 4 * g);
            S[db][0] = S[db][0] * e4; S[db][1] = S[db][1] * e4;
#pragma unroll
            for (int ks = 0; ks < 2; ++ks) {
                const bf16x8 A = *(const bf16x8*)(KLl + (16 * db + r16) * 144 + (32 * ks + 8 * g) * 2);
                S[db][0] = MFMA16(A, Vf[ks][0], S[db][0]); S[db][1] = MFMA16(A, Vf[ks][1], S[db][1]);
            }
        }
        __builtin_amdgcn_sched_barrier(0);
        if (ci + 1 < nchunks) GLA_LOAD(job0 + (ci + 1) * jobstride, t0 + 64);
        BAR_LDS();
#pragma unroll
        for (int ib = 0; ib < 4; ++ib)
#pragma unroll
            for (int ks = 0; ks < 2; ++ks) {
                const bf16x8 A = *(const bf16x8*)(AMl + (16 * ib + r16) * 144 + (32 * ks + 8 * g) * 2);
                o[ib][0] = MFMA16(A, Vf[ks][0], o[ib][0]); o[ib][1] = MFMA16(A, Vf[ks][1], o[ib][1]);
            }
        u32x4 grv[4];
#pragma unroll
        for (int k_ = 0; k_ < 4; ++k_) { const int id_ = tid + 512 * k_, row_ = id_ >> 5, seg_ = id_ & 31;
            grv[k_] = *(const u32x4*)(GRg + (size_t)(t0 + (row_ < nvalid ? row_ : 0)) * 1024 + h * 256 + seg_ * 8); }
#pragma unroll
        for (int ib = 0; ib < 4; ++ib)
#pragma unroll
            for (int j = 0; j < 4; ++j) {
                float s = o[ib][0][j] * o[ib][0][j] + o[ib][1][j] * o[ib][1][j];
                s += __shfl_xor(s, 1); s += __shfl_xor(s, 2); s += __shfl_xor(s, 4); s += __shfl_xor(s, 8);
                if (r16 == 0) SSQ[w * 64 + 16 * ib + 4 * g + j] = s;
            }
        BAR_LDS();
        if (tid < 64) { float t = 0.f;
#pragma unroll
            for (int ww = 0; ww < 8; ++ww) t += SSQ[ww * 64 + tid];
            RSl[tid] = rsqrtf(t * (1.0f / 256) + EPS); }
        BAR_LDS();
#pragma unroll
        for (int ib = 0; ib < 4; ++ib)
#pragma unroll
            for (int j = 0; j < 4; ++j) {
                const int i = 16 * ib + 4 * g + j; const float rs = RSl[i];
                *(bf16_t*)(OTl + i * 528 + (32 * w + r16) * 2) = (bf16_t)(pk2(o[ib][0][j] * rs, 0.f) & 0xffffu);
                *(bf16_t*)(OTl + i * 528 + (32 * w + 16 + r16) * 2) = (bf16_t)(pk2(o[ib][1][j] * rs, 0.f) & 0xffffu);
            }
        BAR_LDS();
#pragma unroll
        for (int k_ = 0; k_ < 4; ++k_) { const int id_ = tid + 512 * k_, row_ = id_ >> 5, seg_ = id_ & 31;
            if (row_ < nvalid) {
                const u32x4 ov = *(const u32x4*)(OTl + row_ * 528 + seg_ * 16);
                const f32x4 ga = *(const f32x4*)(p.in[16] + seg_ * 8), gb = *(const f32x4*)(p.in[16] + seg_ * 8 + 4);
                const u32x4 gr = grv[k_]; u32x4 wv;
                wv.x = pk2(bflo(ov.x) * ga[0] * silu_f(bflo(gr.x)), bfhi(ov.x) * ga[1] * silu_f(bfhi(gr.x)));
                wv.y = pk2(bflo(ov.y) * ga[2] * silu_f(bflo(gr.y)), bfhi(ov.y) * ga[3] * silu_f(bfhi(gr.y)));
                wv.z = pk2(bflo(ov.z) * gb[0] * silu_f(bflo(gr.z)), bfhi(ov.z) * gb[1] * silu_f(bfhi(gr.z)));
                wv.w = pk2(bflo(ov.w) * gb[2] * silu_f(bflo(gr.w)), bfhi(ov.w) * gb[3] * silu_f(bfhi(gr.w)));
                *(u32x4*)(CAT + (size_t)(t0 + row_) * DM + h * 256 + seg_ * 8) = wv;
            }
        }
        BAR_LDS();
        if (ci + 1 < nchunks) { GLA_STORE(); }
        BAR_LDS();
    }
#undef GLA_LOAD
#undef GLA_STORE
    {
        float* sp = s_out + (size_t)(4 * g) * 256 + 32 * w + r16;
#pragma unroll
        for (int db = 0; db < 8; ++db) {
#pragma unroll
            for (int j = 0; j < 4; ++j) { sp[j * 256] = S[db][0][j]; sp[j * 256 + 16] = S[db][1][j]; }
            sp += 16 * 256; asm volatile("" : "+v"(sp));
        }
    }
}

template <int MODE>
__device__ __forceinline__ void attn_item(const Params& p, unsigned char* sm, int h, int tok0, int nrows, int kvt0, int ntiles, int nkeys, int qpos0, const int TIDX) {
    const int tid = TIDX, w = __builtin_amdgcn_readfirstlane(tid >> 6), lane = tid & 63, r16 = lane & 15, g = lane >> 4;
    constexpr int KS = MODE == 0 ? 2 : 4;
    const int c = MODE == 0 ? (w & 1) : 0, rg = MODE == 0 ? (w >> 1) : w, doff = 64 * c;
    const int qrow = 16 * rg + r16; const bool valid = qrow < nrows;
    float* BIAS = (float*)(sm + 71680); float* XCH = (float*)(sm + 72448);
    const bf16_t* qsrc = (const bf16_t*)(p.ws + (MODE == 0 ? WS_DQ : WS_MQ)) + (size_t)(tok0 + (valid ? qrow : 0)) * 512 + h * 128 + doff + 8 * g;
    bf16x8 Qf[KS];
#pragma unroll
    for (int ks = 0; ks < KS; ++ks) Qf[ks] = *(const bf16x8*)(qsrc + 32 * ks);
    BAR_LDS();
    if (MODE == 0 && tid < 192) {
        const int rel = tid - 128, n = rel < 0 ? -rel : rel;
        int bk = n < 8 ? n : min(8 + (31 - __clz((n * n) >> 6)), 15);
        if (rel > 0) bk += 16;
        BIAS[tid] = p.in[8][bk * 4 + h] * LOG2E;
    }
    const unsigned char* kvg = p.ws + WS_KV + (size_t)kvt0 * 32768;
    u32x4 pkk[2], pvv[2];
#define AT_LOAD(t) do { _Pragma("unroll") for (int k_ = 0; k_ < 2; ++k_) { const int id_ = tid + 512 * k_; pkk[k_] = *(const u32x4*)(kvg + (size_t)(t) * 32768 + id_ * 16); pvv[k_] = *(const u32x4*)(kvg + (size_t)(t) * 32768 + 16384 + id_ * 16); } } while (0)
#define AT_STORE(buf) do { unsigned char* b_ = sm + (buf) * 35840; _Pragma("unroll") for (int k_ = 0; k_ < 2; ++k_) { const int id_ = tid + 512 * k_; \
        *(u32x4*)(b_ + (id_ >> 4) * 272 + (id_ & 15) * 16) = pkk[k_]; *(u32x4*)(b_ + 17408 + (id_ >> 3) * 144 + (id_ & 7) * 16) = pvv[k_]; } } while (0)
    AT_LOAD(0); AT_STORE(0);
    BAR_LDS();
    const float SC = (MODE == 0 ? 0.125f : 0.08838834764831845f) * LOG2E;
    float m_run = -1e30f, l_run = 0.f;
    f32x4 O[8];
#pragma unroll
    for (int cb = 0; cb < 8; ++cb) O[cb] = (f32x4){0.f, 0.f, 0.f, 0.f};
    const int qpos = qpos0 + qrow;
    for (int t = 0; t < ntiles; ++t) {
        if (t + 1 < ntiles) AT_LOAD(t + 1);
        const unsigned char* Kb = sm + (t & 1) * 35840; const unsigned char* Vb = Kb + 17408;
        f32x4 s[4];
#pragma unroll
        for (int kb = 0; kb < 4; ++kb) {
            f32x4 acc = (f32x4){0.f, 0.f, 0.f, 0.f};
#pragma unroll
            for (int ks = 0; ks < KS; ++ks) {
                const bf16x8 A = *(const bf16x8*)(Kb + (16 * kb + r16) * 272 + (doff + 32 * ks + 8 * g) * 2);
                acc = MFMA16(A, Qf[ks], acc);
            }
            s[kb] = acc;
        }
        float mx = -1e30f;
        if ((MODE == 1 || (64 * t + 63 - qpos0 <= -128)) && 64 * (t + 1) <= nkeys) {
            const float bfar = MODE == 0 ? BIAS[0] : 0.f;
#pragma unroll
            for (int kb = 0; kb < 4; ++kb)
#pragma unroll
                for (int j = 0; j < 4; ++j) { const float v = s[kb][j] * SC + bfar; s[kb][j] = v; mx = fmaxf(mx, v); }
        } else {
#pragma unroll
            for (int kb = 0; kb < 4; ++kb)
#pragma unroll
                for (int j = 0; j < 4; ++j) {
                    const int kpos = 64 * t + 16 * kb + 4 * g + j;
                    float v = s[kb][j] * SC;
                    if (MODE == 0) { const int rel = kpos - qpos; v += BIAS[max(rel, -128) + 128]; }
                    if (kpos >= nkeys) v = -1e30f;
                    s[kb][j] = v; mx = fmaxf(mx, v);
                }
        }
        mx = fmaxf(mx, __shfl_xor(mx, 16)); mx = fmaxf(mx, __shfl_xor(mx, 32));
        const float mnew = fmaxf(m_run, mx), alpha = __builtin_amdgcn_exp2f(m_run - mnew); m_run = mnew;
        float psum = 0.f;
#pragma unroll
        for (int kb = 0; kb < 4; ++kb)
#pragma unroll
            for (int j = 0; j < 4; ++j) { const float pv_ = __builtin_amdgcn_exp2f(s[kb][j] - mnew); s[kb][j] = pv_; psum += pv_; }
        l_run = l_run * alpha + psum;
#pragma unroll
        for (int cb = 0; cb < 8; ++cb) O[cb] = O[cb] * alpha;
        bf16x8 Pf[2];
#pragma unroll
        for (int k2 = 0; k2 < 2; ++k2) { u32x4 tt; tt.x = pk2(s[2 * k2][0], s[2 * k2][1]); tt.y = pk2(s[2 * k2][2], s[2 * k2][3]); tt.z = pk2(s[2 * k2 + 1][0], s[2 * k2 + 1][1]); tt.w = pk2(s[2 * k2 + 1][2], s[2 * k2 + 1][3]);
            Pf[k2] = __builtin_bit_cast(bf16x8, tt); }
#pragma unroll
        for (int cb = 0; cb < 8; ++cb)
#pragma unroll
            for (int k2 = 0; k2 < 2; ++k2) {
                const u32x2 a0 = *(const u32x2*)(Vb + (16 * cb + r16) * 144 + (32 * k2 + 4 * g) * 2);
                const u32x2 a1 = *(const u32x2*)(Vb + (16 * cb + r16) * 144 + (32 * k2 + 16 + 4 * g) * 2);
                const bf16x8 A = __builtin_bit_cast(bf16x8, ((u32x4){a0.x, a0.y, a1.x, a1.y}));
                O[cb] = MFMA16(A, Pf[k2], O[cb]);
            }
        if (t + 1 < ntiles) AT_STORE((t + 1) & 1);
        BAR_LDS();
    }
#undef AT_LOAD
#undef AT_STORE
    l_run += __shfl_xor(l_run, 16); l_run += __shfl_xor(l_run, 32);
    const float inv = 1.0f / l_run;
    bf16_t* CAT = (bf16_t*)(p.ws + WS_ABUF);
    if (MODE == 1) {
        if (valid) {
#pragma unroll
            for (int cb = 0; cb < 8; ++cb) { u32x2 wv; wv.x = pk2(O[cb][0] * inv, O[cb][1] * inv); wv.y = pk2(O[cb][2] * inv, O[cb][3] * inv);
                *(u32x2*)(CAT + (size_t)(tok0 + qrow) * DM + 1536 + h * 128 + 16 * cb + 4 * g) = wv; }
        }
    } else {
        const float* L = p.in[19];
        const float d1 = wave_sum(L[lane] * L[64 + lane]), d2 = wave_sum(L[128 + lane] * L[192 + lane]);
        const float lam_init = 0.2f, lam = __expf(d1) - __expf(d2) + lam_init;
        if (c == 1) {
#pragma unroll
            for (int cb = 0; cb < 8; ++cb) *(f32x4*)(XCH + (rg * 16 + r16) * 132 + 16 * cb + 4 * g) = O[cb] * inv;
        }
        BAR_LDS();
        if (c == 0) {
            float ss = 0.f;
#pragma unroll
            for (int cb = 0; cb < 8; ++cb) { const f32x4 x1 = *(const f32x4*)(XCH + (rg * 16 + r16) * 132 + 16 * cb + 4 * g); O[cb] = O[cb] * inv - lam * x1;
                ss += O[cb][0] * O[cb][0] + O[cb][1] * O[cb][1] + O[cb][2] * O[cb][2] + O[cb][3] * O[cb][3]; }
            ss += __shfl_xor(ss, 16); ss += __shfl_xor(ss, 32);
            const float rs = rsqrtf(ss * (1.0f / 128) + EPS) * (1.0f - lam_init);
            if (valid) {
#pragma unroll
                for (int cb = 0; cb < 8; ++cb) { const f32x4 gg = *(const f32x4*)(p.in[20] + 16 * cb + 4 * g);
                    u32x2 wv; wv.x = pk2(O[cb][0] * rs * gg[0], O[cb][1] * rs * gg[1]); wv.y = pk2(O[cb][2] * rs * gg[2], O[cb][3] * rs * gg[3]);
                    *(u32x2*)(CAT + (size_t)(tok0 + qrow) * DM + 1024 + h * 128 + 16 * cb + 4 * g) = wv; }
            }
        }
    }
}

__device__ __forceinline__ void phase_mixer(const Params& p, unsigned char* sm, const int TIDX, const int BIDX, const int rep) {
    unsigned* ctr = (unsigned*)(p.ws + WS_CTL) + 64 * rep;
    int* sitem = (int*)(sm + LDS_BYTES - 16);
    for (;;) {
        __syncthreads();
        if (TIDX == 0) *sitem = (int)atomicAdd(ctr, 1u);
        __syncthreads();
        int it = __builtin_amdgcn_readfirstlane(*sitem);
        int tl = TIDX; asm volatile("" : "+v"(tl));
        if (it >= 1760 + 258) break;
        if (it >= 1760) { if (rep == 0) { int tl2 = TIDX; asm volatile("" : "+v"(tl2)); conv_item(p, sm, 1, it - 1760, tl2); } continue; }
        int kind, h, a0, a1, a2, a3, a4, a5; const float* sin = nullptr; float* sout = nullptr;
        if (it < 32) { const int b = it >> 2; h = it & 3; kind = 0; a0 = (b * 32) * 4 + h; a1 = 32; a2 = b * 2048; a3 = 64; a4 = 0; a5 = 0; sout = p.out + O_GSP + (size_t)(b * 4 + h) * 32768; }
        else if (it < 544 || (it >= 608 && it < 1120)) { it -= (it < 544 ? 32 : 96); const int qc = 31 - (it >> 5), bh = it & 31, b = bh >> 2; h = bh & 3; kind = 1;
            a0 = b * 2048 + qc * 64; a1 = 64; a2 = (b * 4 + h) * 32; a3 = qc + 1; a4 = (qc + 1) * 64; a5 = qc * 64; }
        else if (it < 608) { it -= 544; const int sb = it >> 2; h = it & 3; kind = 1; a0 = TP + sb * 32; a1 = 32; a2 = 1024 + (sb * 4 + h) * 17; a3 = 17; a4 = 1056; a5 = 1024; }
        else if (it < 1184) { it -= 1120; const int sb = it >> 2; h = it & 3; kind = 0; a0 = (256 + sb) * 4 + h; a1 = 1; a2 = TP + sb * 32; a3 = 32; a4 = 0; a5 = 0;
            sin = p.in[5] + (size_t)(sb * 4 + h) * 32768; sout = p.out + O_GSS + (size_t)(sb * 4 + h) * 32768; }
        else if (it < 1696) { it -= 1184; const int qb = it & 15, bh = it >> 4, b = bh >> 2; h = bh & 3; kind = 2; a0 = b * 2048 + qb * 128; a1 = 128; a2 = 2112 + (b * 4 + h) * 4; a3 = 4; a4 = 256; a5 = 0; }
        else { it -= 1696; const int sb = it >> 2; h = it & 3; kind = 2; a0 = TP + sb * 32; a1 = 32; a2 = 2240 + (sb * 4 + h) * 4; a3 = 4; a4 = 256; a5 = 0; }
#ifndef MIXSEL
#define MIXSEL 7
#endif
#ifndef REPSEL
#define REPSEL 3
#endif
        if (rep == 1) { const bool isgp = (kind == 0 && a1 == 32); if (isgp && !(REPSEL & 1)) continue; if (!isgp && !(REPSEL & 2)) continue; }
        if (kind == 0) { if (MIXSEL & 1) gla_item(p, sm, h, a0, 4, a1, a2, a3, sin, sout, tl); }
        else if (kind == 1) { if (MIXSEL & 2) attn_item<0>(p, sm, h, a0, a1, a2, a3, a4, a5, tl); }
        else { if (MIXSEL & 4) attn_item<1>(p, sm, h, a0, a1, a2, a3, a4, a5, tl); }
    }
}

#define XB_TMO      128
#define XB_XCNT(j)  (256  + 64 * (j))
#define XB_XSUB(j)  (1280 + 64 * (j))
#define XB_XGEN(j)  (2304 + 64 * (j))
#define XB_TOP      3328
#define XB_TOPGEN   3392
#define XCD_BAR_WORDS 3456
#define XB_SPIN_CAP (1u << 22)
__device__ __forceinline__ unsigned xb_ld(unsigned* p)              { return __hip_atomic_load(p, __ATOMIC_RELAXED, __HIP_MEMORY_SCOPE_AGENT); }
__device__ __forceinline__ unsigned xb_add(unsigned* p, unsigned v) { return __hip_atomic_fetch_add(p, v, __ATOMIC_RELAXED, __HIP_MEMORY_SCOPE_AGENT); }
__device__ __forceinline__ unsigned xb_xcc_id() { return (unsigned)__builtin_amdgcn_s_getreg((3 << 11) | 20) & 0xFu; }
#define XB_SPIN(cond, bar) do { unsigned _sp = 0; while (cond) { __builtin_amdgcn_s_sleep(1); \
    if ((++_sp & 255u) == 0u) { if (xb_ld(&(bar)[XB_TMO])) break; if (_sp > XB_SPIN_CAP) { atomicAdd(&(bar)[XB_TMO], 1u); break; } } } } while (0)
__device__ __forceinline__ void xcd_barrier_complete(unsigned* bar, unsigned x, unsigned& nloc, unsigned& nx) {
    const unsigned G = gridDim.x * gridDim.y * gridDim.z;
    unsigned sum, cnt, mine, sp = 0u;
    for (;;) {
        sum = 0u; cnt = 0u; mine = 0u;
#pragma unroll
        for (unsigned j = 0; j < 16; ++j) { const unsigned c = xb_ld(&bar[XB_XCNT(j)]); sum += c; cnt += (c > 0u) ? 1u : 0u; mine = (j == x) ? c : mine; }
        if (sum == G) break;
        __builtin_amdgcn_s_sleep(1);
        if ((++sp & 255u) == 0u) { if (xb_ld(&bar[XB_TMO])) break; if (sp > XB_SPIN_CAP) { atomicAdd(&bar[XB_TMO], 1u); break; } }
    }
    nloc = mine > 0u ? mine : 1u; nx = cnt > 0u ? cnt : 1u;
}
__device__ __forceinline__ void xcd_barrier(unsigned* bar, volatile LAS unsigned* st, const int TIDX) {
    asm volatile("s_waitcnt vmcnt(0)" ::: "memory");
    __syncthreads();
    if (TIDX == 0) {
        const unsigned x = xb_xcc_id();
        __builtin_amdgcn_s_waitcnt(0);
        unsigned nloc = st[0], nx = st[1];
        if (nloc == 0u) { xcd_barrier_complete(bar, x, nloc, nx); st[0] = nloc; st[1] = nx; }
        const unsigned old = xb_add(&bar[XB_XSUB(x)], 1u);
        const unsigned gen = old / nloc;
        if (old + 1u == (gen + 1u) * nloc) {
            __builtin_amdgcn_fence(__ATOMIC_RELEASE, "agent");
            asm volatile("s_waitcnt vmcnt(0)" ::: "memory");
            const unsigned og = xb_add(&bar[XB_TOP], 1u);
            const unsigned tg = og / nx;
            if (og + 1u == (tg + 1u) * nx) xb_add(&bar[XB_TOPGEN], 1u);
            else XB_SPIN(xb_ld(&bar[XB_TOPGEN]) == tg, bar);
            __builtin_amdgcn_fence(__ATOMIC_ACQUIRE, "agent");
            xb_add(&bar[XB_XGEN(x)], 1u);
            asm volatile("s_waitcnt vmcnt(0)" ::: "memory");
        } else {
            XB_SPIN(xb_ld(&bar[XB_XGEN(x)]) == gen, bar);
            __builtin_amdgcn_fence(__ATOMIC_ACQUIRE, "agent");
            asm volatile("s_waitcnt vmcnt(0)" ::: "memory");
        }
    }
    __syncthreads();
}

struct KArgs { Params p; int ph_lo, ph_hi, rep_ph, pad_; };
__global__ __launch_bounds__(512, 2) void mega(Params p_unused, int ph_lo_unused, int ph_hi_unused, int rep_unused, int pad_unused) {
    extern __shared__ __attribute__((aligned(16))) unsigned char shm[];
    typedef const KArgs __attribute__((address_space(4))) * kargp_t;
    kargp_t ka0 = (kargp_t)__builtin_amdgcn_kernarg_segment_ptr();
    const int ph_lo = ka0->ph_lo, ph_hi = ka0->ph_hi, rep_ph = ka0->rep_ph;
    volatile LAS unsigned* xst = (volatile LAS unsigned*)(LAS unsigned char*)(shm + LDS_BYTES - 32);
    const int wave_s = __builtin_amdgcn_readfirstlane((int)threadIdx.x >> 6);
    if (threadIdx.x == 0) { xst[0] = 0u; xst[1] = 0u; (void)xb_add(&((unsigned*)(ka0->p.ws + WS_CTL))[XB_XCNT(xb_xcc_id())], 1u); }
    __syncthreads();
    for (int ph = ph_lo; ph < ph_hi; ++ph)
    for (int rep = 0; rep < ((ph == rep_ph) ? 2 : 1); ++rep) {
        kargp_t ka = ka0; asm volatile("" : "+s"(ka));
        int wv_ = wave_s; asm volatile("" : "+s"(wv_));
        int TIDX = (wv_ << 6) | (int)__builtin_amdgcn_mbcnt_hi(~0u, __builtin_amdgcn_mbcnt_lo(~0u, 0u)), BIDX = blockIdx.x; asm volatile("" : "+v"(TIDX)); asm volatile("" : "+s"(BIDX));
        Params p;
#pragma unroll
        for (int i = 0; i < 30; ++i) p.in[i] = ka->p.in[i];
        p.out = ka->p.out; p.ws = ka->p.ws;
        const bool is_gemm = (ph == 1 || ph == 2 || ph == 4 || ph == 7 || ph == 9 || ph == 10);
#ifndef PHSEL
#define PHSEL 0xfff
#endif
        if (is_gemm && (PHSEL & 2)) {
            pg8::Sched S; float alpha = 1.f;
            S.G = gridDim.x; S.c = BIDX; S.K = DM; S.split = 0;
            S.g1.A = nullptr; S.g1.Bt = nullptr; S.g1.nM = 1; S.g1.nN = 1; S.g1.mode = 0;
            const bf16_t* ABUF = (const bf16_t*)(p.ws + WS_ABUF); const bf16_t* Hb = (const bf16_t*)(p.ws + WS_H);
            if (ph == 1 || ph == 9) { S.g0.A = ABUF; S.g0.Bt = (const bf16_t*)(p.ws + (ph == 1 ? WS_WFI : WS_WFI2)); S.g0.nM = 66; S.g0.nN = 43; S.g0.mode = pg8::EPI_SWIGLU; }
            else if (ph == 2 || ph == 10) { S.g0.A = Hb; S.g0.Bt = (const bf16_t*)(p.ws + (ph == 2 ? WS_WFO : WS_WFO2)); S.g0.nM = 66; S.g0.nN = 8; S.g0.mode = ph == 2 ? pg8::EPI_RESX : pg8::EPI_RESIN; S.K = DFF; alpha = 0.5f; }
            else if (ph == 4) { S.g0.A = ABUF; S.g0.Bt = (const bf16_t*)(p.ws + WS_WIN); S.g0.nM = 66; S.g0.nN = 22; S.g0.mode = pg8::EPI_WIN; }
            else { S.g0.A = ABUF; S.g0.Bt = (const bf16_t*)(p.ws + WS_WO); S.g0.nM = 66; S.g0.nN = 8; S.g0.mode = pg8::EPI_RESIN; alpha = 1.f; }
            S.n0 = S.g0.nM * S.g0.nN; S.ntot = S.n0;
            if (ph == 2 || ph == 7 || ph == 10) { S.split = 1; S.g0.nM = 64; S.n0 = 512; S.ntot = 640; }
            if (ph == 1) { S.g1.A = (const bf16_t*)(p.ws + WS_AMEM); S.g1.Bt = (const bf16_t*)(p.ws + WS_WMEM); S.g1.nM = 8; S.g1.nN = 4; S.g1.mode = pg8::EPI_MEMKV; S.ntot = S.n0 + 32; }
            pg8::gemm_phase((LAS unsigned char*)shm, p, S, alpha, TIDX);
            if (ph == 1 && rep == 0) conv_queue(p, shm, 0, 206, (unsigned*)(p.ws + WS_CTL) + 8, TIDX);
        } else if (ph == 0 && (PHSEL & 1)) phase_prep0(p, shm, TIDX, BIDX);
        else if (ph == 3 && (PHSEL & 8)) phase_norm(p, shm, 0, TIDX, BIDX);
        else if (ph == 5 && (PHSEL & 32)) phase_post(p, shm, TIDX, BIDX);
        else if (ph == 6 && (PHSEL & 64)) phase_mixer(p, shm, TIDX, BIDX, rep);
        else if (ph == 8 && (PHSEL & 8)) phase_norm(p, shm, 1, TIDX, BIDX);
        else if (ph == 11 && (PHSEL & 8)) phase_norm(p, shm, 2, TIDX, BIDX);
        if (ph + 1 < ph_hi) { if (ph_hi < 0) cg::this_grid().sync(); else xcd_barrier((unsigned*)(p.ws + WS_CTL), xst, TIDX); }
    }
}

extern "C" void kernel_launch(void* const* d_in, const int* in_sizes, int n_in, void* d_out, int out_size, void* d_ws, size_t ws_size, hipStream_t stream) {
    static int grid = 0;
    if (grid == 0) {
        if (n_in != 30 || ws_size < WS_END) { fprintf(stderr, "kernel_launch: need 30 inputs and >= %zu bytes of workspace; got n_in %d ws %zu\n", (size_t)WS_END, n_in, ws_size); grid = -1; return; }
        if (hipFuncSetAttribute((const void*)mega, hipFuncAttributeMaxDynamicSharedMemorySize, LDS_BYTES) != hipSuccess) { fprintf(stderr, "kernel_launch: hipFuncSetAttribute failed\n"); grid = -1; return; }
        int dev = 0, cus = 0, per_cu = 0;
        (void)hipGetDevice(&dev); (void)hipDeviceGetAttribute(&cus, hipDeviceAttributeMultiprocessorCount, dev);
        (void)hipOccupancyMaxActiveBlocksPerMultiprocessor(&per_cu, (const void*)mega, 512, LDS_BYTES);
        if (per_cu < 1) { fprintf(stderr, "kernel_launch: occupancy query says %d blocks per CU\n", per_cu); per_cu = 1; }
        (void)hipGetLastError();
        grid = cus;
    }
    if (grid < 0) return;
    Params p{};
    for (int i = 0; i < 30; ++i) p.in[i] = (const float*)d_in[i];
    p.out = (float*)d_out; p.ws = (unsigned char*)d_ws;
    if (hipMemsetAsync((char*)d_ws + WS_CTL, 0, 16384, stream) != hipSuccess) { fprintf(stderr, "kernel_launch: memset of control words failed\n"); return; }
#if MK_MULTI
    for (int ph = 0; ph < 12; ++ph) { hipLaunchKernelGGL(mega, dim3(grid), dim3(512), LDS_BYTES, stream, p, ph, ph + 1, -1, 0); }
#else
    int lo = 0, hi = 12, rp = REP_PH, pd = 0;
    void* args[] = {(void*)&p, (void*)&lo, (void*)&hi, (void*)&rp, (void*)&pd};
    hipError_t e = hipLaunchCooperativeKernel((const void*)mega, dim3(grid), dim3(512), args, LDS_BYTES, stream);
    if (e != hipSuccess) fprintf(stderr, "cooperative launch failed: %s (grid %d)\n", hipGetErrorString(e), grid);
#endif
}
```

```cpp
#include <hip/hip_runtime.h>
#include <hip/hip_cooperative_groups.h>
#include <cstdio>
namespace cg = cooperative_groups;

#ifndef REP_PH
#define REP_PH -1
#endif
#ifndef MK_MULTI
#define MK_MULTI 0
#endif

#define LAS __attribute__((address_space(3)))
typedef unsigned short bf16_t;
typedef short bf16x8 __attribute__((ext_vector_type(8)));
typedef short bf16x4 __attribute__((ext_vector_type(4)));
typedef float f32x4 __attribute__((ext_vector_type(4)));
typedef unsigned u32x4 __attribute__((ext_vector_type(4)));
typedef unsigned u32x2 __attribute__((ext_vector_type(2)));

constexpr int TP = 16384, TT = 16896, DM = 2048, DFF = 5504, NFF = 11008, NIN = 5632;
constexpr float EPS = 1e-6f, LOG2E = 1.4426950408889634f;
constexpr size_t O_DKP = 34603008, O_DVP = O_DKP + 8388608, O_GSP = O_DVP + 8388608, O_MKP = O_GSP + 1048576, O_MVP = O_MKP + 1048576,
                 O_DKS = O_MVP + 1048576, O_DVS = O_DKS + 262144, O_GSS = O_DVS + 262144;
constexpr size_t WS_CTL = 0;
constexpr size_t WS_WFI = 16384;
constexpr size_t WS_WFO = WS_WFI + (size_t)NFF * DM * 2;
constexpr size_t WS_WIN = WS_WFO + (size_t)DM * DFF * 2;
constexpr size_t WS_WMEM = WS_WIN + (size_t)NIN * DM * 2;
constexpr size_t WS_WO = WS_WMEM + (size_t)1024 * DM * 2;
constexpr size_t WS_ABUF = WS_WO + (size_t)DM * DM * 2;
constexpr size_t WS_AMEM = WS_ABUF + (size_t)TT * DM * 2;
constexpr size_t WS_H = WS_AMEM + (size_t)2048 * DM * 2;
constexpr size_t WS_MKRAW = WS_H + (size_t)TT * DFF * 2;
constexpr size_t WS_KV = WS_MKRAW + (size_t)2048 * 512 * 4;
constexpr size_t WS_VTG = WS_KV + (size_t)2496 * 32768;
constexpr size_t WS_PART = WS_VTG;
constexpr size_t WS_WFI2 = WS_VTG + (size_t)1088 * 32768;
constexpr size_t WS_WFO2 = WS_WFI2 + (size_t)NFF * DM * 2;
constexpr size_t WS_END = WS_WFO2 + (size_t)DM * DFF * 2;
static_assert((size_t)8 * 512 * DM * 4 <= (size_t)1088 * 32768, "partials alias overflow");
constexpr size_t WS_GQ = WS_H;
constexpr size_t WS_GK = WS_GQ + (size_t)TT * 512 * 2;
constexpr size_t WS_GV = WS_GK + (size_t)TT * 512 * 2;
constexpr size_t WS_GR = WS_GV + (size_t)TT * 1024 * 2;
constexpr size_t WS_DQ = WS_GR + (size_t)TT * 1024 * 2;
constexpr size_t WS_MQ = WS_DQ + (size_t)TT * 512 * 2;
constexpr size_t WS_GG = WS_MQ + (size_t)TT * 512 * 2;
static_assert(WS_GG + (size_t)TT * 512 * 4 <= WS_MKRAW, "proj alias overflow");
constexpr size_t WS_QE = WS_WFI;
constexpr size_t WS_KE = WS_QE + (size_t)1088 * 16384;
constexpr size_t WS_KLT = WS_KE + (size_t)1088 * 16384;
constexpr size_t WS_EBL = WS_KLT + (size_t)1088 * 16384;
static_assert(WS_EBL + (size_t)1088 * 512 <= WS_WIN, "gla alias overflow");
constexpr int LDS_BYTES = 147456;

struct Params { const float* in[30]; float* out; unsigned char* ws; };

__device__ __forceinline__ unsigned pk2(float lo, float hi) { unsigned r; asm("v_cvt_pk_bf16_f32 %0, %1, %2" : "=v"(r) : "v"(lo), "v"(hi)); return r; }
__device__ __forceinline__ float bflo(unsigned u) { return __uint_as_float(u << 16); }
__device__ __forceinline__ float bfhi(unsigned u) { return __uint_as_float(u & 0xffff0000u); }
__device__ __forceinline__ float bf2f(bf16_t b) { return __uint_as_float(((unsigned)b) << 16); }
__device__ __forceinline__ float wave_sum(float v) {
#pragma unroll
    for (int o = 1; o < 64; o <<= 1) v += __shfl_xor(v, o);
    return v;
}
__device__ __forceinline__ float silu_f(float x) { return x * __builtin_amdgcn_rcpf(1.0f + __expf(-x)); }
__device__ __forceinline__ float logsigmoid_f(float x) { return fminf(x, 0.f) - __logf(1.0f + __expf(-fabsf(x))); }
#define LDSWAIT() asm volatile("s_waitcnt lgkmcnt(0)" ::: "memory")
#define BAR_LDS() do { asm volatile("s_waitcnt lgkmcnt(0)" ::: "memory"); __builtin_amdgcn_s_barrier(); asm volatile("" ::: "memory"); } while (0)
#define MFMA16(a, b, c) __builtin_amdgcn_mfma_f32_16x16x32_bf16((a), (b), (c), 0, 0, 0)

namespace pg8 {
constexpr int BM = 256, BK = 64, HALF = 128, HTB = HALF * BK * 2, STAGE_BYTES = 8 * HTB, NXCD = 8, WGM = 8;
__device__ __forceinline__ int lds_byte(int r, int c) { const int st = (r >> 4) * 2 + (c >> 5), rr = r & 15, cc = c & 31, ob = rr * 64 + cc * 2; return st * 1024 + (ob ^ (((ob >> 9) & 1) << 5)); }
__device__ __forceinline__ void stage_rc(int b, int& R, int& C) { const int st = b / 1024, sb = b % 1024, swz = sb ^ (((sb >> 9) & 1) << 5); R = (st >> 1) * 16 + swz / 64; C = (st & 1) * 32 + (swz % 64) / 2; }
__device__ __forceinline__ int perm32(int rho) { const int n = rho >> 4, i = rho & 15; return 8 * (i >> 2) + 4 * n + (i & 3); }

struct Unit { const char* a; const char* b; int pm, pn, gid, nt, atomic, part; };
struct GDesc { const bf16_t* A; const bf16_t* Bt; int nM, nN, mode; };
enum { EPI_SWIGLU = 0, EPI_RESX = 1, EPI_RESIN = 2, EPI_WIN = 3, EPI_MEMKV = 4 };

struct Sched {
    GDesc g0, g1; int n0, ntot, G, c, K, split;
    __device__ __forceinline__ bool next(int i, Unit& u) const {
        const long L = (long)i * G + c; if (L >= ntot) return false;
        if (split && L >= 512) {
            const int s = (int)L - 512, part = s & 7, P = K / 128, p0 = (P * part) >> 3, p1 = (P * (part + 1)) >> 3;
            u.pm = 64 + (s >> 6); u.pn = (s >> 3) & 7; u.gid = 0; u.nt = 2 * (p1 - p0); u.atomic = 1; u.part = part;
            u.a = (const char*)g0.A + (size_t)u.pm * 256 * K * 2 + (size_t)p0 * 256; u.b = (const char*)g0.Bt + (size_t)u.pn * 256 * K * 2 + (size_t)p0 * 256;
            return true;
        }
        const bool second = L >= n0; int wgid = second ? (int)L - n0 : (int)L;
        const int nM = second ? g1.nM : g0.nM, nN = second ? g1.nN : g0.nN, nwg = nM * nN;
        { const int q = nwg / NXCD, r = nwg % NXCD, xcd = wgid % NXCD, off = wgid / NXCD; wgid = (xcd < r ? xcd * (q + 1) : r * (q + 1) + (xcd - r) * q) + off; }
        const int nig = WGM * nN, gid = wgid / nig, fm = gid * WGM, gsz = (nM - fm) < WGM ? (nM - fm) : WGM;
        u.pm = fm + ((wgid % nig) % gsz); u.pn = (wgid % nig) / gsz; u.gid = second ? 1 : 0; u.nt = K / BK; u.atomic = 0; u.part = 0;
        const bf16_t* A = second ? g1.A : g0.A; const bf16_t* B = second ? g1.Bt : g0.Bt;
        u.a = (const char*)A + (size_t)u.pm * 256 * K * 2; u.b = (const char*)B + (size_t)u.pn * 256 * K * 2;
        return true;
    }
};

__device__ __forceinline__ void epilogue(const Params& p, int mode, int atomic, float alpha, const f32x4 (&acc)[2][2][4][2], int pm, int pn, int wr, int wc, int fr, int fq) {
    const int row0 = pm * 256 + wr * 64 + fr, cw = wc * 32 + fq * 8;
    if (mode == EPI_SWIGLU) {
        bf16_t* H = (bf16_t*)(p.ws + WS_H);
#pragma unroll
        for (int ai = 0; ai < 2; ++ai)
#pragma unroll
            for (int m = 0; m < 4; ++m) {
                const int row = row0 + ai * 128 + m * 16;
                const f32x4 g0 = acc[ai][0][m][0], g1 = acc[ai][0][m][1], u0 = acc[ai][1][m][0], u1 = acc[ai][1][m][1];
                u32x4 w;
                w.x = pk2(silu_f(g0[0]) * u0[0], silu_f(g0[1]) * u0[1]); w.y = pk2(silu_f(g0[2]) * u0[2], silu_f(g0[3]) * u0[3]);
                w.z = pk2(silu_f(g1[0]) * u1[0], silu_f(g1[1]) * u1[1]); w.w = pk2(silu_f(g1[2]) * u1[2], silu_f(g1[3]) * u1[3]);
                *(u32x4*)(H + (size_t)row * DFF + pn * 128 + cw) = w;
            }
    } else if ((mode == EPI_RESX || mode == EPI_RESIN) && atomic) {
        float* P = (float*)(p.ws + WS_PART) + (size_t)(atomic - 1) * 512 * DM;
#pragma unroll
        for (int ai = 0; ai < 2; ++ai)
#pragma unroll
            for (int m = 0; m < 4; ++m) {
                float* xr = P + (size_t)(row0 - TP + ai * 128 + m * 16) * DM + pn * 256 + cw;
#pragma unroll
                for (int bj = 0; bj < 2; ++bj) { *(f32x4*)(xr + bj * 128) = acc[ai][bj][m][0]; *(f32x4*)(xr + bj * 128 + 4) = acc[ai][bj][m][1]; }
            }
    } else if (mode == EPI_RESX || mode == EPI_RESIN) {
        float* X = p.out;
#pragma unroll
        for (int ai = 0; ai < 2; ++ai)
#pragma unroll
            for (int m = 0; m < 4; ++m) {
                const int row = row0 + ai * 128 + m * 16;
                const float* src = (mode == EPI_RESIN) ? (X + (size_t)row * DM) : (row < TP ? p.in[0] + (size_t)row * DM : p.in[1] + (size_t)(row - TP) * DM);
#pragma unroll
                for (int bj = 0; bj < 2; ++bj) {
                    const int col = pn * 256 + bj * 128 + cw;
                    const f32x4 s0 = *(const f32x4*)(src + col), s1 = *(const f32x4*)(src + col + 4);
                    *(f32x4*)(X + (size_t)row * DM + col) = s0 + alpha * acc[ai][bj][m][0];
                    *(f32x4*)(X + (size_t)row * DM + col + 4) = s1 + alpha * acc[ai][bj][m][1];
                }
            }
    } else if (mode == EPI_WIN) {
        if (pn < 14 || pn == 18 || pn == 19) {
            bf16_t* O; int ld, c0; float sc = 1.f;
            if (pn < 2) { O = (bf16_t*)(p.ws + WS_GQ); ld = 512; c0 = pn * 256; sc = 0.08838834764831845f; }
            else if (pn < 4) { O = (bf16_t*)(p.ws + WS_GK); ld = 512; c0 = (pn - 2) * 256; }
            else if (pn < 8) { O = (bf16_t*)(p.ws + WS_GV); ld = 1024; c0 = (pn - 4) * 256; }
            else if (pn < 12) { O = (bf16_t*)(p.ws + WS_GR); ld = 1024; c0 = (pn - 8) * 256; }
            else if (pn < 14) { O = (bf16_t*)(p.ws + WS_DQ); ld = 512; c0 = (pn - 12) * 256; }
            else { O = (bf16_t*)(p.ws + WS_MQ); ld = 512; c0 = (pn - 18) * 256; }
#pragma unroll
            for (int ai = 0; ai < 2; ++ai)
#pragma unroll
                for (int m = 0; m < 4; ++m) {
                    const int row = row0 + ai * 128 + m * 16;
#pragma unroll
                    for (int bj = 0; bj < 2; ++bj) {
                        const f32x4 v0 = acc[ai][bj][m][0] * sc, v1 = acc[ai][bj][m][1] * sc;
                        u32x4 w; w.x = pk2(v0[0], v0[1]); w.y = pk2(v0[2], v0[3]); w.z = pk2(v1[0], v1[1]); w.w = pk2(v1[2], v1[3]);
                        *(u32x4*)(O + (size_t)row * ld + c0 + bj * 128 + cw) = w;
                    }
                }
        } else if (pn < 18) {
            const bool isv = pn >= 16; const int c0 = (pn - (isv ? 16 : 14)) * 256;
#pragma unroll
            for (int ai = 0; ai < 2; ++ai)
#pragma unroll
                for (int m = 0; m < 4; ++m) {
                    const int row = row0 + ai * 128 + m * 16;
                    float* dst = row < TP ? p.out + (isv ? O_DVP : O_DKP) + (size_t)row * 512 : p.out + (isv ? O_DVS : O_DKS) + (size_t)(row - TP) * 512;
#pragma unroll
                    for (int bj = 0; bj < 2; ++bj) {
                        *(f32x4*)(dst + c0 + bj * 128 + cw) = acc[ai][bj][m][0];
                        *(f32x4*)(dst + c0 + bj * 128 + cw + 4) = acc[ai][bj][m][1];
                    }
                }
        } else {
            float* GG = (float*)(p.ws + WS_GG); const int c0 = (pn - 20) * 256; const float* bias = p.in[15];
#pragma unroll
            for (int bj = 0; bj < 2; ++bj) {
                const int col = c0 + bj * 128 + cw;
                const f32x4 b0 = *(const f32x4*)(bias + col), b1 = *(const f32x4*)(bias + col + 4);
#pragma unroll
                for (int ai = 0; ai < 2; ++ai)
#pragma unroll
                    for (int m = 0; m < 4; ++m) {
                        const int row = row0 + ai * 128 + m * 16;
                        f32x4 v0 = acc[ai][bj][m][0] + b0, v1 = acc[ai][bj][m][1] + b1;
#pragma unroll
                        for (int j = 0; j < 4; ++j) { v0[j] = logsigmoid_f(v0[j]) * 0.0625f; v1[j] = logsigmoid_f(v1[j]) * 0.0625f; }
                        *(f32x4*)(GG + (size_t)row * 512 + col) = v0; *(f32x4*)(GG + (size_t)row * 512 + col + 4) = v1;
                    }
            }
        }
    } else {
        const bool isv = pn >= 2; const int c0 = (pn - (isv ? 2 : 0)) * 256;
        float* dst = isv ? p.out + O_MVP : (float*)(p.ws + WS_MKRAW);
#pragma unroll
        for (int ai = 0; ai < 2; ++ai)
#pragma unroll
            for (int m = 0; m < 4; ++m) {
                const int row = row0 + ai * 128 + m * 16;
#pragma unroll
                for (int bj = 0; bj < 2; ++bj) {
                    *(f32x4*)(dst + (size_t)row * 512 + c0 + bj * 128 + cw) = acc[ai][bj][m][0];
                    *(f32x4*)(dst + (size_t)row * 512 + c0 + bj * 128 + cw + 4) = acc[ai][bj][m][1];
                }
            }
    }
}

__device__ __forceinline__ void gemm_phase(LAS unsigned char* lds, const Params& p, const Sched& S, float alpha, const int TIDX) {
    const int tid = TIDX, wid = __builtin_amdgcn_readfirstlane(tid >> 6), lane = tid & 63, wr = wid >> 2, wc = wid & 3, fr = lane & 15, fq = lane >> 4;
    const int K = S.K;
    unsigned voffA[2], voffB[2];
#pragma unroll
    for (int i = 0; i < 2; ++i) { int R, C; stage_rc(tid * 16 + i * 8192, R, C); const int Rb = (R & ~31) + perm32(R & 31);
        voffA[i] = (unsigned)(R * K + C) * 2u; voffB[i] = (unsigned)(Rb * K + C) * 2u; }
    const size_t kstep = (size_t)(BK * 2);
    const size_t hstep = (size_t)HALF * K * 2;
    const unsigned ldsw = (unsigned)wid * 1024u;
    const int aoff = lds_byte(wr * 64 + fr, fq * 8), boff = lds_byte(wc * 32 + fr, fq * 8);
#define PG8_SA(b, h) (((b) * 2 + (h)) * HTB)
#define PG8_SB(b, h) ((4 + (b) * 2 + (h)) * HTB)
#define PG8_STAGE(bufoff, gbase, voff) do { _Pragma("unroll") for (int _i = 0; _i < 2; ++_i) \
        __builtin_amdgcn_global_load_lds((const unsigned*)((const char*)(gbase) + (voff)[_i]), (LAS unsigned*)(lds + (bufoff) + ldsw + _i * 8192), 16, 0, 0); } while (0)
#define PG8_LDA(dst, b, h) do { _Pragma("unroll") for (int m = 0; m < 4; ++m) _Pragma("unroll") for (int k = 0; k < 2; ++k) dst[m][k] = *(const LAS bf16x8*)(lds + PG8_SA(b, h) + aoff + m * 2048 + k * 1024); } while (0)
#define PG8_LDB(dst, b, h) do { _Pragma("unroll") for (int n = 0; n < 2; ++n) _Pragma("unroll") for (int k = 0; k < 2; ++k) dst[n][k] = *(const LAS bf16x8*)(lds + PG8_SB(b, h) + boff + n * 2048 + k * 1024); } while (0)
#define PG8_MMA(ai, bj, At, Bt) do { __builtin_amdgcn_s_setprio(1); _Pragma("unroll") for (int m = 0; m < 4; ++m) _Pragma("unroll") for (int n = 0; n < 2; ++n) _Pragma("unroll") for (int k = 0; k < 2; ++k) \
        acc[ai][bj][m][n] = __builtin_amdgcn_mfma_f32_16x16x32_bf16(Bt[n][k], At[m][k], acc[ai][bj][m][n], 0, 0, 0); __builtin_amdgcn_s_setprio(0); } while (0)
#define PG8_WAIT_V(n) asm volatile("s_waitcnt vmcnt(" #n ")" ::: "memory")
#define PG8_WAIT_L(n) asm volatile("s_waitcnt lgkmcnt(" #n ")" ::: "memory")
#define PG8_BAR __builtin_amdgcn_s_barrier()
#define PG8_SCHED __builtin_amdgcn_sched_barrier(0)
    Unit cur, nxt; int ui = 0;
    if (!S.next(0, cur)) return;
    f32x4 acc[2][2][4][2];
#pragma unroll
    for (int a = 0; a < 2; ++a)
#pragma unroll
        for (int b = 0; b < 2; ++b)
#pragma unroll
            for (int m = 0; m < 4; ++m)
#pragma unroll
                for (int n = 0; n < 2; ++n) acc[a][b][m][n] = (f32x4){0.f, 0.f, 0.f, 0.f};
    bf16x8 At[4][2], B0[2][2], B1[2][2];
    const char* cA = cur.a; const char* cB = cur.b; int nt = cur.nt;
    PG8_STAGE(PG8_SB(0, 0), cB, voffB); PG8_STAGE(PG8_SA(0, 0), cA, voffA); PG8_STAGE(PG8_SB(0, 1), cB + hstep, voffB); PG8_STAGE(PG8_SA(0, 1), cA + hstep, voffA);
    if (wr == 1) PG8_BAR;
    PG8_WAIT_V(4); PG8_BAR;
    PG8_STAGE(PG8_SB(1, 0), cB + kstep, voffB); PG8_STAGE(PG8_SA(1, 0), cA + kstep, voffA); PG8_STAGE(PG8_SB(1, 1), cB + hstep + kstep, voffB);
    PG8_WAIT_V(6); PG8_BAR;
    for (;;) {
        const bool has_next = S.next(ui + 1, nxt);
        const char* nA = has_next ? nxt.a : cA; const char* nB = has_next ? nxt.b : cB;
        for (int t = 0; t < nt; t += 2) {
            const bool last = (t == nt - 2);
            const char* a1 = cA + (size_t)(t + 1) * kstep;
            const char* a2 = last ? nA : cA + (size_t)(t + 2) * kstep; const char* b2 = last ? nB : cB + (size_t)(t + 2) * kstep;
            const char* a3 = a2 + kstep; const char* b3 = b2 + kstep;
            PG8_LDB(B0, 0, 0); PG8_SCHED; PG8_LDA(At, 0, 0); PG8_STAGE(PG8_SA(1, 1), a1 + hstep, voffA);
            PG8_WAIT_L(8); PG8_BAR; PG8_WAIT_L(0); PG8_MMA(0, 0, At, B0); PG8_BAR; PG8_SCHED;
            PG8_LDB(B1, 0, 1); PG8_STAGE(PG8_SB(0, 0), b2, voffB);
            PG8_BAR; PG8_WAIT_L(0); PG8_MMA(0, 1, At, B1); PG8_BAR;
            PG8_LDA(At, 0, 1); PG8_STAGE(PG8_SA(0, 0), a2, voffA);
            PG8_BAR; PG8_WAIT_L(0); PG8_MMA(1, 0, At, B0); PG8_BAR; PG8_SCHED;
            PG8_STAGE(PG8_SB(0, 1), b2 + hstep, voffB);
            PG8_WAIT_V(6); PG8_BAR; PG8_MMA(1, 1, At, B1); PG8_BAR;
            PG8_LDB(B0, 1, 0); PG8_SCHED; PG8_LDA(At, 1, 0); PG8_STAGE(PG8_SA(0, 1), a2 + hstep, voffA);
            PG8_WAIT_L(8); PG8_BAR; PG8_WAIT_L(0); PG8_MMA(0, 0, At, B0); PG8_BAR; PG8_SCHED;
            PG8_LDB(B1, 1, 1); PG8_STAGE(PG8_SB(1, 0), b3, voffB);
            PG8_BAR; PG8_WAIT_L(0); PG8_MMA(0, 1, At, B1); PG8_BAR;
            PG8_LDA(At, 1, 1); PG8_STAGE(PG8_SA(1, 0), a3, voffA);
            PG8_BAR; PG8_WAIT_L(0); PG8_MMA(1, 0, At, B0); PG8_BAR; PG8_SCHED;
            PG8_STAGE(PG8_SB(1, 1), b3 + hstep, voffB);
            PG8_WAIT_V(6); PG8_BAR; PG8_MMA(1, 1, At, B1); PG8_BAR;
        }
        epilogue(p, cur.gid ? S.g1.mode : S.g0.mode, cur.atomic ? cur.part + 1 : 0, alpha, acc, cur.pm, cur.pn, wr, wc, fr, fq);
        if (!has_next) break;
#pragma unroll
        for (int a = 0; a < 2; ++a)
#pragma unroll
            for (int b = 0; b < 2; ++b)
#pragma unroll
                for (int m = 0; m < 4; ++m)
#pragma unroll
                    for (int n = 0; n < 2; ++n) acc[a][b][m][n] = (f32x4){0.f, 0.f, 0.f, 0.f};
        cur = nxt; cA = nA; cB = nB; nt = cur.nt; ++ui;
    }
    PG8_WAIT_V(0);
    if (wr == 0) PG8_BAR;
    PG8_BAR;
#undef PG8_SA
#undef PG8_SB
#undef PG8_STAGE
#undef PG8_LDA
#undef PG8_LDB
#undef PG8_MMA
#undef PG8_WAIT_V
#undef PG8_WAIT_L
#undef PG8_BAR
#undef PG8_SCHED
}
}

__device__ __forceinline__ void tr_matrix(const float* __restrict__ W, int K, int N, bf16_t* __restrict__ WT, int NBdst, int kind, const float* __restrict__ wg2,
                                          float* scr, int it0, int it1, int nw, int lane) {
    const int KB = K / 64, nitems = KB * NBdst; (void)KB;
    for (int it = it0; it < (it1 < nitems ? it1 : nitems); it += nw) {
        const int kb = it / NBdst, nb = it - kb * NBdst, k0 = kb * 64, n0 = nb * 32;
        int nsrc = n0;
        if (kind == 1) { const int pn = n0 >> 8, bj = (n0 >> 7) & 1, i = n0 & 127; nsrc = bj * DFF + pn * 128 + i; }
        else if (kind == 2) nsrc = n0 < 3072 ? n0 : n0 + 16;
        if (kind == 2 && n0 >= 5120) {
            const int n = lane & 31;
            float g2[16];
#pragma unroll
            for (int r = 0; r < 16; ++r) g2[r] = wg2[r * 512 + (n0 - 5120) + n];
#pragma unroll 4
            for (int i = 0; i < 32; ++i) {
                const int kk = 2 * i + (lane >> 5);
                const f32x4* wr = (const f32x4*)(W + (size_t)(k0 + kk) * N + 3072);
                const f32x4 a0 = wr[0], a1 = wr[1], a2 = wr[2], a3 = wr[3];
                float s = a0[0] * g2[0] + a0[1] * g2[1] + a0[2] * g2[2] + a0[3] * g2[3] + a1[0] * g2[4] + a1[1] * g2[5] + a1[2] * g2[6] + a1[3] * g2[7]
                        + a2[0] * g2[8] + a2[1] * g2[9] + a2[2] * g2[10] + a2[3] * g2[11] + a3[0] * g2[12] + a3[1] * g2[13] + a3[2] * g2[14] + a3[3] * g2[15];
                scr[kk * 33 + n] = s;
            }
        } else {
            float tv[32]; const float* wp = W + (size_t)(k0 + (lane >> 5)) * N + nsrc + (lane & 31);
#pragma unroll
            for (int i = 0; i < 32; ++i) tv[i] = wp[(size_t)(2 * i) * N];
#pragma unroll
            for (int i = 0; i < 32; ++i) scr[(2 * i + (lane >> 5)) * 33 + (lane & 31)] = tv[i];
        }
        LDSWAIT();
        const int c = lane & 7;
#pragma unroll
        for (int j = 0; j < 4; ++j) {
            const int n = (lane >> 3) + 8 * j; const float* s = scr + (8 * c) * 33 + n;
            u32x4 o; o.x = pk2(s[0], s[33]); o.y = pk2(s[66], s[99]); o.z = pk2(s[132], s[165]); o.w = pk2(s[198], s[231]);
            *(u32x4*)(WT + (size_t)(n0 + n) * K + k0 + 8 * c) = o;
        }
        LDSWAIT();
    }
}

__device__ __forceinline__ void norm_row_bf16(const float* __restrict__ x, const float* __restrict__ g, bf16_t* __restrict__ o, int lane) {
    f32x4 v[8]; float s = 0.f;
#pragma unroll
    for (int j = 0; j < 8; ++j) { v[j] = ((const f32x4*)x)[j * 64 + lane]; s += v[j][0] * v[j][0] + v[j][1] * v[j][1] + v[j][2] * v[j][2] + v[j][3] * v[j][3]; }
    s = wave_sum(s); const float rs = rsqrtf(s * (1.0f / DM) + EPS);
#pragma unroll
    for (int j = 0; j < 8; ++j) { const f32x4 gg = ((const f32x4*)g)[j * 64 + lane]; u32x2 w; w.x = pk2(v[j][0] * rs * gg[0], v[j][1] * rs * gg[1]); w.y = pk2(v[j][2] * rs * gg[2], v[j][3] * rs * gg[3]); ((u32x2*)o)[j * 64 + lane] = w; }
}

__device__ __forceinline__ void phase_prep0(const Params& p, unsigned char* sm, const int TIDX, const int BIDX) {
    const int tid = TIDX, wid = tid >> 6, lane = tid & 63, wgid = BIDX * 8 + wid, nw = gridDim.x * 8;
    float* scr = (float*)sm + wid * (64 * 33);
    if (BIDX == 0 && tid == 0) { ((unsigned*)(p.ws + WS_CTL))[0] = 0u; }
    for (int r = wgid; r < TT + 2048; r += nw) {
        if (r < TT) norm_row_bf16(r < TP ? p.in[0] + (size_t)r * DM : p.in[1] + (size_t)(r - TP) * DM, p.in[9], (bf16_t*)(p.ws + WS_ABUF) + (size_t)r * DM, lane);
        else norm_row_bf16(p.in[2] + (size_t)(r - TT) * DM, p.in[21], (bf16_t*)(p.ws + WS_AMEM) + (size_t)(r - TT) * DM, lane);
    }
    tr_matrix(p.in[10], DM, NFF, (bf16_t*)(p.ws + WS_WFI), NFF / 32, 1, nullptr, scr, wgid, 1 << 30, nw, lane);
    tr_matrix(p.in[22], DM, 1024, (bf16_t*)(p.ws + WS_WMEM), 1024 / 32, 0, nullptr, scr, wgid, 1 << 30, nw, lane);
}

__device__ __forceinline__ void load_row(const Params& p, int r, int mode, int lane, f32x4 (&v)[8]) {
    float* X = p.out;
    if (r < TP) {
#pragma unroll
        for (int j = 0; j < 8; ++j) v[j] = ((const f32x4*)(X + (size_t)r * DM))[j * 64 + lane];
    } else {
        const float* base = mode == 0 ? p.in[1] + (size_t)(r - TP) * DM : X + (size_t)r * DM;
        const float alpha = mode == 1 ? 1.0f : 0.5f;
        const float* P = (const float*)(p.ws + WS_PART) + (size_t)(r - TP) * DM;
#pragma unroll
        for (int j = 0; j < 8; ++j) {
            f32x4 a = (f32x4){0.f, 0.f, 0.f, 0.f};
#pragma unroll
            for (int q = 0; q < 8; ++q) a += ((const f32x4*)(P + (size_t)q * 512 * DM))[j * 64 + lane];
            v[j] = ((const f32x4*)base)[j * 64 + lane] + alpha * a;
            if (mode < 2) ((f32x4*)(X + (size_t)r * DM))[j * 64 + lane] = v[j];
        }
    }
}
__device__ __forceinline__ void phase_norm(const Params& p, unsigned char* sm, int mode, const int TIDX, const int BIDX) {
    const int tid = TIDX, wid = tid >> 6, lane = tid & 63, wgid = BIDX * 8 + wid, nw = gridDim.x * 8;
    float* X = p.out;
    const float* g = mode == 0 ? p.in[12] : (mode == 1 ? p.in[26] : p.in[29]);
    for (int r = wgid; r < TT; r += nw) {
        f32x4 v[8]; float s = 0.f;
        load_row(p, r, mode, lane, v);
#pragma unroll
        for (int j = 0; j < 8; ++j) s += v[j][0] * v[j][0] + v[j][1] * v[j][1] + v[j][2] * v[j][2] + v[j][3] * v[j][3];
        s = wave_sum(s); const float rs = rsqrtf(s * (1.0f / DM) + EPS);
        if (mode < 2) {
            bf16_t* o = (bf16_t*)(p.ws + WS_ABUF) + (size_t)r * DM;
#pragma unroll
            for (int j = 0; j < 8; ++j) { const f32x4 gg = ((const f32x4*)g)[j * 64 + lane]; u32x2 w; w.x = pk2(v[j][0] * rs * gg[0], v[j][1] * rs * gg[1]); w.y = pk2(v[j][2] * rs * gg[2], v[j][3] * rs * gg[3]); ((u32x2*)o)[j * 64 + lane] = w; }
        } else {
#pragma unroll
            for (int j = 0; j < 8; ++j) { const f32x4 gg = ((const f32x4*)g)[j * 64 + lane]; ((f32x4*)(X + (size_t)r * DM))[j * 64 + lane] = v[j] * rs * gg; }
        }
    }
}

__device__ __forceinline__ void unpack16(const u32x4 a, const u32x4 b, float (&f)[16]) {
    f[0] = bflo(a.x); f[1] = bfhi(a.x); f[2] = bflo(a.y); f[3] = bfhi(a.y); f[4] = bflo(a.z); f[5] = bfhi(a.z); f[6] = bflo(a.w); f[7] = bfhi(a.w);
    f[8] = bflo(b.x); f[9] = bfhi(b.x); f[10] = bflo(b.y); f[11] = bfhi(b.y); f[12] = bflo(b.z); f[13] = bfhi(b.z); f[14] = bflo(b.w); f[15] = bfhi(b.w);
}

__device__ __forceinline__ void phase_post(const Params& p, unsigned char* sm, const int TIDX, const int BIDX) {
    const int tid = TIDX, wid = tid >> 6, lane = tid & 63, wgid = BIDX * 8 + wid, nw = gridDim.x * 8;
    {
        bf16_t* DQ = (bf16_t*)(p.ws + WS_DQ); bf16_t* MQ = (bf16_t*)(p.ws + WS_MQ);
        const float* gq = p.in[17]; const float* gm = p.in[23];
        float g1[8], g2[8];
#pragma unroll
        for (int i = 0; i < 8; ++i) { g1[i] = gq[(8 * lane + i) & 63]; g2[i] = gm[(8 * lane + i) & 127]; }
        for (int t = wgid; t < TT; t += nw) {
            u32x4 a = *(const u32x4*)(DQ + (size_t)t * 512 + 8 * lane);
            u32x4 b = *(const u32x4*)(MQ + (size_t)t * 512 + 8 * lane);
            float x[8] = {bflo(a.x), bfhi(a.x), bflo(a.y), bfhi(a.y), bflo(a.z), bfhi(a.z), bflo(a.w), bfhi(a.w)};
            float y[8] = {bflo(b.x), bfhi(b.x), bflo(b.y), bfhi(b.y), bflo(b.z), bfhi(b.z), bflo(b.w), bfhi(b.w)};
            float s1 = 0.f, s2 = 0.f;
#pragma unroll
            for (int i = 0; i < 8; ++i) { s1 += x[i] * x[i]; s2 += y[i] * y[i]; }
            s1 += __shfl_xor(s1, 1); s1 += __shfl_xor(s1, 2); s1 += __shfl_xor(s1, 4);
            s2 += __shfl_xor(s2, 1); s2 += __shfl_xor(s2, 2); s2 += __shfl_xor(s2, 4); s2 += __shfl_xor(s2, 8);
            const float r1 = rsqrtf(s1 * (1.0f / 64) + EPS), r2 = rsqrtf(s2 * (1.0f / 128) + EPS);
            u32x4 oa, ob;
            oa.x = pk2(x[0] * r1 * g1[0], x[1] * r1 * g1[1]); oa.y = pk2(x[2] * r1 * g1[2], x[3] * r1 * g1[3]); oa.z = pk2(x[4] * r1 * g1[4], x[5] * r1 * g1[5]); oa.w = pk2(x[6] * r1 * g1[6], x[7] * r1 * g1[7]);
            ob.x = pk2(y[0] * r2 * g2[0], y[1] * r2 * g2[1]); ob.y = pk2(y[2] * r2 * g2[2], y[3] * r2 * g2[3]); ob.z = pk2(y[4] * r2 * g2[4], y[5] * r2 * g2[5]); ob.w = pk2(y[6] * r2 * g2[6], y[7] * r2 * g2[7]);
            *(u32x4*)(DQ + (size_t)t * 512 + 8 * lane) = oa; *(u32x4*)(MQ + (size_t)t * 512 + 8 * lane) = ob;
        }
    }
    const int r = tid >> 3, cseg = tid & 7;
    for (int id = BIDX; id < 2496; id += gridDim.x) {
        const float* ksrc; const float* vsrc; float* kdst = nullptr; const float* gain = nullptr; int G = 0, nvalid = 64;
        if (id < 1024) { const int bh = id >> 5, tile = id & 31, b = bh >> 2, h = bh & 3; const size_t o = ((size_t)(b * 2048 + tile * 64)) * 512 + h * 128;
            ksrc = p.out + O_DKP + o; kdst = p.out + O_DKP + o; vsrc = p.out + O_DVP + o; G = 64; gain = p.in[18]; }
        else if (id < 2112) { const int q = id - 1024, sbh = q / 17, tile = q - sbh * 17, sb = sbh >> 2, h = sbh & 3;
            if (tile < 16) { const size_t o = ((size_t)(sb * 1024 + tile * 64)) * 512 + h * 128; ksrc = p.in[3] + o; vsrc = p.in[4] + o; }
            else { const size_t o = ((size_t)(sb * 32)) * 512 + h * 128; ksrc = p.out + O_DKS + o; kdst = p.out + O_DKS + o; vsrc = p.out + O_DVS + o; G = 64; gain = p.in[18]; nvalid = 32; } }
        else if (id < 2240) { const int q = id - 2112, bh = q >> 2, tile = q & 3, b = bh >> 2, h = bh & 3; const size_t o = ((size_t)(b * 256 + tile * 64)) * 512 + h * 128;
            ksrc = (const float*)(p.ws + WS_MKRAW) + o; kdst = p.out + O_MKP + o; vsrc = p.out + O_MVP + o; G = 128; gain = p.in[24]; }
        else { const int q = id - 2240, sbh = q >> 2, tile = q & 3, sb = sbh >> 2, h = sbh & 3; const size_t o = ((size_t)(sb * 256 + tile * 64)) * 512 + h * 128;
            ksrc = p.in[6] + o; vsrc = p.in[7] + o; }
        bf16_t* Kt = (bf16_t*)(p.ws + WS_KV + (size_t)id * 32768); bf16_t* Vt = Kt + 8192;
        const bool ok = r < nvalid;
        f32x4 k4[4], v4[4];
#pragma unroll
        for (int i = 0; i < 4; ++i) {
            k4[i] = ok ? *(const f32x4*)(ksrc + (size_t)r * 512 + cseg * 16 + i * 4) : (f32x4){0.f, 0.f, 0.f, 0.f};
            v4[i] = ok ? *(const f32x4*)(vsrc + (size_t)r * 512 + cseg * 16 + i * 4) : (f32x4){0.f, 0.f, 0.f, 0.f};
        }
        if (G) {
            float s = 0.f;
#pragma unroll
            for (int i = 0; i < 4; ++i) s += k4[i][0] * k4[i][0] + k4[i][1] * k4[i][1] + k4[i][2] * k4[i][2] + k4[i][3] * k4[i][3];
            s += __shfl_xor(s, 1); s += __shfl_xor(s, 2); if (G == 128) s += __shfl_xor(s, 4);
            const float rs = rsqrtf(s / (float)G + EPS);
#pragma unroll
            for (int i = 0; i < 4; ++i) { const f32x4 gg = *(const f32x4*)(gain + ((cseg * 16 + i * 4) & (G - 1))); k4[i] = k4[i] * rs * gg; }
            if (ok) {
#pragma unroll
                for (int i = 0; i < 4; ++i) *(f32x4*)(kdst + (size_t)r * 512 + cseg * 16 + i * 4) = k4[i];
            }
        }
        { u32x4 w0, w1; w0.x = pk2(k4[0][0], k4[0][1]); w0.y = pk2(k4[0][2], k4[0][3]); w0.z = pk2(k4[1][0], k4[1][1]); w0.w = pk2(k4[1][2], k4[1][3]);
          w1.x = pk2(k4[2][0], k4[2][1]); w1.y = pk2(k4[2][2], k4[2][3]); w1.z = pk2(k4[3][0], k4[3][1]); w1.w = pk2(k4[3][2], k4[3][3]);
          *(u32x4*)(Kt + r * 128 + cseg * 16) = w0; *(u32x4*)(Kt + r * 128 + cseg * 16 + 8) = w1; }
        bf16_t* T = (bf16_t*)sm;
        __syncthreads();
#pragma unroll
        for (int i = 0; i < 4; ++i)
#pragma unroll
            for (int j = 0; j < 4; ++j) T[(cseg * 16 + i * 4 + j) * 72 + r] = (bf16_t)(pk2(v4[i][j], 0.f) & 0xffffu);
        __syncthreads();
        { const int col = tid >> 2, seg = tid & 3; const u32x4 a = *(const u32x4*)(T + col * 72 + seg * 16), b = *(const u32x4*)(T + col * 72 + seg * 16 + 8);
          *(u32x4*)(Vt + col * 64 + seg * 16) = a; *(u32x4*)(Vt + col * 64 + seg * 16 + 8) = b; }
    }
    float* Gs = (float*)sm;
    float* SEG = (float*)(sm + 33792);
    bf16_t* TTb = (bf16_t*)(sm + 35840);
    bf16_t* VV = (bf16_t*)(sm + 54272);
    for (int job = BIDX; job < 1088; job += gridDim.x) {
        const int c = job >> 2, h = job & 3;
        const int t0 = c < 256 ? c * 64 : TP + (c - 256) * 32, nvalid = c < 256 ? 64 : 32;
        const bool ok = r < nvalid;
        __syncthreads();
        {
            const float* gg = (const float*)(p.ws + WS_GG) + (size_t)(t0 + r) * 512 + h * 128 + cseg * 16;
#pragma unroll
            for (int i = 0; i < 4; ++i) { float z = 0.f; asm volatile("" : "+v"(z)); f32x4 v = (f32x4){z, z, z, z}; if (ok) v = *(const f32x4*)(gg + i * 4); *(f32x4*)(Gs + r * 132 + cseg * 16 + i * 4) = v; }
        }
        __syncthreads();
        { const int seg = tid >> 7, d = tid & 127; float s = 0.f;
#pragma unroll
          for (int i = 0; i < 16; ++i) s += Gs[(seg * 16 + i) * 132 + d];
          SEG[seg * 128 + d] = s;
          __syncthreads();
          float run = 0.f;
          for (int s2 = 0; s2 < seg; ++s2) run += SEG[s2 * 128 + d];
#pragma unroll
          for (int i = 0; i < 16; ++i) { run += Gs[(seg * 16 + i) * 132 + d]; Gs[(seg * 16 + i) * 132 + d] = run; }
        }
        __syncthreads();
        {
            float q[16], k[16];
            if (ok) {
                const bf16_t* gq = (const bf16_t*)(p.ws + WS_GQ) + (size_t)(t0 + r) * 512 + h * 128 + cseg * 16;
                const bf16_t* gk = (const bf16_t*)(p.ws + WS_GK) + (size_t)(t0 + r) * 512 + h * 128 + cseg * 16;
                unpack16(*(const u32x4*)gq, *(const u32x4*)(gq + 8), q); unpack16(*(const u32x4*)gk, *(const u32x4*)(gk + 8), k);
            } else {
#pragma unroll
                for (int i = 0; i < 16; ++i) { q[i] = 0.f; k[i] = 0.f; }
            }
            float qe[16], ke[16];
#pragma unroll
            for (int i = 0; i < 16; ++i) {
                const float b = Gs[r * 132 + cseg * 16 + i], bl = Gs[63 * 132 + cseg * 16 + i];
                qe[i] = q[i] * __expf(b); ke[i] = k[i] * __expf(-b);
                TTb[(cseg * 16 + i) * 72 + r] = (bf16_t)(pk2(k[i] * __expf(bl - b), 0.f) & 0xffffu);
                if (r == 63) ((float*)(p.ws + WS_EBL))[job * 128 + cseg * 16 + i] = __expf(bl);
            }
            bf16_t* QE = (bf16_t*)(p.ws + WS_QE) + (size_t)job * 8192 + r * 128 + cseg * 16;
            bf16_t* KE = (bf16_t*)(p.ws + WS_KE) + (size_t)job * 8192 + r * 128 + cseg * 16;
            u32x4 w0, w1;
            w0.x = pk2(qe[0], qe[1]); w0.y = pk2(qe[2], qe[3]); w0.z = pk2(qe[4], qe[5]); w0.w = pk2(qe[6], qe[7]);
            w1.x = pk2(qe[8], qe[9]); w1.y = pk2(qe[10], qe[11]); w1.z = pk2(qe[12], qe[13]); w1.w = pk2(qe[14], qe[15]);
            *(u32x4*)QE = w0; *(u32x4*)(QE + 8) = w1;
            w0.x = pk2(ke[0], ke[1]); w0.y = pk2(ke[2], ke[3]); w0.z = pk2(ke[4], ke[5]); w0.w = pk2(ke[6], ke[7]);
            w1.x = pk2(ke[8], ke[9]); w1.y = pk2(ke[10], ke[11]); w1.z = pk2(ke[12], ke[13]); w1.w = pk2(ke[14], ke[15]);
            *(u32x4*)KE = w0; *(u32x4*)(KE + 8) = w1;
        }
        {
            const bf16_t* gv = (const bf16_t*)(p.ws + WS_GV) + (size_t)(t0 + r) * 1024 + h * 256 + cseg * 32;
#pragma unroll
            for (int i = 0; i < 4; ++i) {
                const u32x4 a = ok ? *(const u32x4*)(gv + i * 8) : (u32x4){0u, 0u, 0u, 0u};
                const int e = cseg * 32 + i * 8;
                VV[(e + 0) * 72 + r] = (bf16_t)(a.x & 0xffffu); VV[(e + 1) * 72 + r] = (bf16_t)(a.x >> 16);
                VV[(e + 2) * 72 + r] = (bf16_t)(a.y & 0xffffu); VV[(e + 3) * 72 + r] = (bf16_t)(a.y >> 16);
                VV[(e + 4) * 72 + r] = (bf16_t)(a.z & 0xffffu); VV[(e + 5) * 72 + r] = (bf16_t)(a.z >> 16);
                VV[(e + 6) * 72 + r] = (bf16_t)(a.w & 0xffffu); VV[(e + 7) * 72 + r] = (bf16_t)(a.w >> 16);
            }
        }
        __syncthreads();
        { const int d = tid >> 2, seg = tid & 3; bf16_t* KLT = (bf16_t*)(p.ws + WS_KLT) + (size_t)job * 8192 + d * 64 + seg * 16;
          *(u32x4*)KLT = *(const u32x4*)(TTb + d * 72 + seg * 16); *(u32x4*)(KLT + 8) = *(const u32x4*)(TTb + d * 72 + seg * 16 + 8); }
        { const int e = tid >> 1, seg = tid & 1; bf16_t* VT = (bf16_t*)(p.ws + WS_VTG) + (size_t)job * 16384 + e * 64 + seg * 32;
#pragma unroll
          for (int i = 0; i < 4; ++i) *(u32x4*)(VT + i * 8) = *(const u32x4*)(VV + e * 72 + seg * 32 + i * 8); }
    }
}

__device__ __forceinline__ void conv_item(const Params& p, unsigned char* sm, int list, int j, const int TIDX) {
    const int wid = TIDX >> 6, lane = TIDX & 63; float* scr = (float*)sm + wid * (64 * 33);
    if (list == 0) {
        if (j < 86) tr_matrix(p.in[11], DFF, DM, (bf16_t*)(p.ws + WS_WFO), DM / 32, 0, nullptr, scr, j * 64 + wid, j * 64 + 64, 8, lane);
        else if (j < 174) tr_matrix(p.in[13], DM, 5136, (bf16_t*)(p.ws + WS_WIN), NIN / 32, 2, p.in[14], scr, (j - 86) * 64 + wid, (j - 86) * 64 + 64, 8, lane);
        else tr_matrix(p.in[25], DM, DM, (bf16_t*)(p.ws + WS_WO), DM / 32, 0, nullptr, scr, (j - 174) * 64 + wid, (j - 174) * 64 + 64, 8, lane);
    } else {
        if (j < 172) tr_matrix(p.in[27], DM, NFF, (bf16_t*)(p.ws + WS_WFI2), NFF / 32, 1, nullptr, scr, j * 64 + wid, j * 64 + 64, 8, lane);
        else tr_matrix(p.in[28], DFF, DM, (bf16_t*)(p.ws + WS_WFO2), DM / 32, 0, nullptr, scr, (j - 172) * 64 + wid, (j - 172) * 64 + 64, 8, lane);
    }
}
__device__ __forceinline__ void conv_queue(const Params& p, unsigned char* sm, int list, int nitems, unsigned* ctr, const int TIDX) {
    int* sitem = (int*)(sm + LDS_BYTES - 16);
    for (;;) {
        __syncthreads();
        if (TIDX == 0) *sitem = (int)atomicAdd(ctr, 1u);
        __syncthreads();
        const int j = __builtin_amdgcn_readfirstlane(*sitem);
        if (j >= nitems) break;
        int tl = TIDX; asm volatile("" : "+v"(tl));
        conv_item(p, sm, list, j, tl);
    }
}

__device__ __forceinline__ void gla_item(const Params& p, unsigned char* sm, int h, int job0, int jobstride, int nchunks, int tok0, int nvalid, const float* s_init, float* s_out, const int TIDX) {
    const int tid = TIDX, w = __builtin_amdgcn_readfirstlane(tid >> 6), lane = tid & 63, r16 = lane & 15, g = lane >> 4;
    unsigned char* QEl = sm; unsigned char* KEl = sm + 17408; unsigned char* KLl = sm + 34816; unsigned char* VTl = sm + 53248; unsigned char* AMl = sm + 90112;
    float* EBl = (float*)(sm + 99328); float* SSQ = (float*)(sm + 99840); float* RSl = (float*)(sm + 101888); unsigned char* OTl = sm + 102400; float* GNl = (float*)(sm + 136192);
    const bf16_t* QEg = (const bf16_t*)(p.ws + WS_QE); const bf16_t* KEg = (const bf16_t*)(p.ws + WS_KE); const bf16_t* KLg = (const bf16_t*)(p.ws + WS_KLT);
    const bf16_t* VTg = (const bf16_t*)(p.ws + WS_VTG); const float* EBg = (const float*)(p.ws + WS_EBL); const bf16_t* GRg = (const bf16_t*)(p.ws + WS_GR);
    bf16_t* CAT = (bf16_t*)(p.ws + WS_ABUF);
    f32x4 S[8][2];
#pragma unroll
    for (int db = 0; db < 8; ++db) { S[db][0] = (f32x4){0.f, 0.f, 0.f, 0.f}; S[db][1] = (f32x4){0.f, 0.f, 0.f, 0.f}; }
    if (s_init) {
        const float* sp = s_init + (size_t)(4 * g) * 256 + 32 * w + r16;
#pragma unroll
        for (int db = 0; db < 8; ++db) {
#pragma unroll
            for (int j = 0; j < 4; ++j) { S[db][0][j] = sp[j * 256]; S[db][1][j] = sp[j * 256 + 16]; }
            sp += 16 * 256; asm volatile("" : "+v"(sp));
        }
    }
    u32x4 pq[2], pk[2], pl[2], pv[4]; f32x4 pe;
#define GLA_LOAD(job, t0) do { \
        _Pragma("unroll") for (int k_ = 0; k_ < 2; ++k_) { const int id_ = tid + 512 * k_; pq[k_] = *(const u32x4*)(QEg + (size_t)(job) * 8192 + id_ * 8); pk[k_] = *(const u32x4*)(KEg + (size_t)(job) * 8192 + id_ * 8); pl[k_] = *(const u32x4*)(KLg + (size_t)(job) * 8192 + id_ * 8); } \
        _Pragma("unroll") for (int k_ = 0; k_ < 4; ++k_) { const int id_ = tid + 512 * k_; pv[k_] = *(const u32x4*)(VTg + (size_t)(job) * 16384 + id_ * 8); } \
        pe = tid < 32 ? *(const f32x4*)(EBg + (size_t)(job) * 128 + tid * 4) : (f32x4){0.f, 0.f, 0.f, 0.f}; } while (0)
#define GLA_STORE() do { \
        _Pragma("unroll") for (int k_ = 0; k_ < 2; ++k_) { const int id_ = tid + 512 * k_; *(u32x4*)(QEl + (id_ >> 4) * 272 + (id_ & 15) * 16) = pq[k_]; *(u32x4*)(KEl + (id_ >> 4) * 272 + (id_ & 15) * 16) = pk[k_]; *(u32x4*)(KLl + (id_ >> 3) * 144 + (id_ & 7) * 16) = pl[k_]; } \
        _Pragma("unroll") for (int k_ = 0; k_ < 4; ++k_) { const int id_ = tid + 512 * k_; *(u32x4*)(VTl + (id_ >> 3) * 144 + (id_ & 7) * 16) = pv[k_]; } \
        if (tid < 32) *(f32x4*)(EBl + tid * 4) = pe; } while (0)
    BAR_LDS();
    GLA_LOAD(job0, tok0);
    GLA_STORE();
    if (tid < 64) *(f32x4*)(GNl + tid * 4) = *(const f32x4*)(p.in[16] + tid * 4);
    BAR_LDS();
    for (int ci = 0; ci < nchunks; ++ci) {
        const int t0 = tok0 + ci * 64;
        {
            const int ib = w >> 1;
#pragma unroll
            for (int jbi = 0; jbi < 2; ++jbi) {
                const int jb = 2 * (w & 1) + jbi; f32x4 acc = (f32x4){0.f, 0.f, 0.f, 0.f};
#pragma unroll
                for (int ks = 0; ks < 4; ++ks) {
                    const bf16x8 A = *(const bf16x8*)(QEl + (16 * ib + r16) * 272 + (32 * ks + 8 * g) * 2);
                    const bf16x8 B = *(const bf16x8*)(KEl + (16 * jb + r16) * 272 + (32 * ks + 8 * g) * 2);
                    acc = MFMA16(A, B, acc);
                }
#pragma unroll
                for (int j = 0; j < 4; ++j) { const int i = 16 * ib + 4 * g + j, jj = 16 * jb + r16; const float v = jj <= i ? acc[j] : 0.f;
                    *(bf16_t*)(AMl + i * 144 + jj * 2) = (bf16_t)(pk2(v, 0.f) & 0xffffu); }
            }
        }
        f32x4 o[4][2];
#pragma unroll
        for (int ib = 0; ib < 4; ++ib) { o[ib][0] = (f32x4){0.f, 0.f, 0.f, 0.f}; o[ib][1] = (f32x4){0.f, 0.f, 0.f, 0.f}; }
#pragma unroll
        for (int ks = 0; ks < 4; ++ks) {
            bf16x8 Sf[2];
#pragma unroll
            for (int eb = 0; eb < 2; ++eb) {
                u32x4 t; t.x = pk2(S[2 * ks][eb][0], S[2 * ks][eb][1]); t.y = pk2(S[2 * ks][eb][2], S[2 * ks][eb][3]);
                t.z = pk2(S[2 * ks + 1][eb][0], S[2 * ks + 1][eb][1]); t.w = pk2(S[2 * ks + 1][eb][2], S[2 * ks + 1][eb][3]);
                Sf[eb] = __builtin_bit_cast(bf16x8, t);
            }
            bf16x8 Aq[4];
#pragma unroll
            for (int ib = 0; ib < 4; ++ib) {
                const u32x2 a0 = *(const u32x2*)(QEl + (16 * ib + r16) * 272 + (32 * ks + 4 * g) * 2);
                const u32x2 a1 = *(const u32x2*)(QEl + (16 * ib + r16) * 272 + (32 * ks + 16 + 4 * g) * 2);
                Aq[ib] = __builtin_bit_cast(bf16x8, ((u32x4){a0.x, a0.y, a1.x, a1.y}));
            }
            __builtin_amdgcn_sched_barrier(0);
#pragma unroll
            for (int ib = 0; ib < 4; ++ib) { o[ib][0] = MFMA16(Aq[ib], Sf[0], o[ib][0]); o[ib][1] = MFMA16(Aq[ib], Sf[1], o[ib][1]); }
            __builtin_amdgcn_sched_barrier(0);
        }
        bf16x8 Vf[2][2];
#pragma unroll
        for (int ks = 0; ks < 2; ++ks)
#pragma unroll
            for (int eb = 0; eb < 2; ++eb) Vf[ks][eb] = *(const bf16x8*)(VTl + (32 * w + 16 * eb + r16) * 144 + (32 * ks + 8 * g) * 2);
#pragma unroll
        for (int dp = 0; dp < 4; ++dp) {
            bf16x8 Ak[2][2]; f32x4 e4[2];
#pragma unroll
            for (int q = 0; q < 2; ++q) { const int db = 2 * dp + q; e4[q] = *(const f32x4*)(EBl + 16 * db + 4 * g);
#pragma unroll
                for (int ks = 0; ks < 2; ++ks) Ak[q][ks] = *(const bf16x8*)(KLl + (16 * db + r16) * 144 + (32 * ks + 8 * g) * 2); }
            __builtin_amdgcn_sched_barrier(0);
#pragma unroll
            for (int q = 0; q < 2; ++q) { const int db = 2 * dp + q;
                S[db][0] = S[db][0] * e4[q]; S[db][1] = S[db][1] * e4[q];
#pragma unroll
                for (int ks = 0; ks < 2; ++ks) { S[db][0] = MFMA16(Ak[q][ks], Vf[ks][0], S[db][0]); S[db][1] = MFMA16(Ak[q][ks], Vf[ks][1], S[db][1]); } }
            __builtin_amdgcn_sched_barrier(0);
        }
        __builtin_amdgcn_sched_barrier(0);
        if (ci + 1 < nchunks) GLA_LOAD(job0 + (ci + 1) * jobstride, t0 + 64);
        BAR_LDS();
#pragma unroll
        for (int ib = 0; ib < 4; ++ib)
#pragma unroll
            for (int ks = 0; ks < 2; ++ks) {
                const bf16x8 A = *(const bf16x8*)(AMl + (16 * ib + r16) * 144 + (32 * ks + 8 * g) * 2);
                o[ib][0] = MFMA16(A, Vf[ks][0], o[ib][0]); o[ib][1] = MFMA16(A, Vf[ks][1], o[ib][1]);
            }
        u32x4 grv[4];
#pragma unroll
        for (int k_ = 0; k_ < 4; ++k_) { const int id_ = tid + 512 * k_, row_ = id_ >> 5, seg_ = id_ & 31;
            grv[k_] = *(const u32x4*)(GRg + (size_t)(t0 + (row_ < nvalid ? row_ : 0)) * 1024 + h * 256 + seg_ * 8); }
#pragma unroll
        for (int ib = 0; ib < 4; ++ib)
#pragma unroll
            for (int j = 0; j < 4; ++j) {
                float s = o[ib][0][j] * o[ib][0][j] + o[ib][1][j] * o[ib][1][j];
                s += __shfl_xor(s, 1); s += __shfl_xor(s, 2); s += __shfl_xor(s, 4); s += __shfl_xor(s, 8);
                if (r16 == 0) SSQ[w * 64 + 16 * ib + 4 * g + j] = s;
            }
        BAR_LDS();
        if (tid < 64) { float t = 0.f;
#pragma unroll
            for (int ww = 0; ww < 8; ++ww) t += SSQ[ww * 64 + tid];
            RSl[tid] = rsqrtf(t * (1.0f / 256) + EPS); }
        BAR_LDS();
#pragma unroll
        for (int ib = 0; ib < 4; ++ib)
#pragma unroll
            for (int j = 0; j < 4; ++j) {
                const int i = 16 * ib + 4 * g + j; const float rs = RSl[i];
                *(bf16_t*)(OTl + i * 528 + (32 * w + r16) * 2) = (bf16_t)(pk2(o[ib][0][j] * rs, 0.f) & 0xffffu);
                *(bf16_t*)(OTl + i * 528 + (32 * w + 16 + r16) * 2) = (bf16_t)(pk2(o[ib][1][j] * rs, 0.f) & 0xffffu);
            }
        BAR_LDS();
#pragma unroll
        for (int k_ = 0; k_ < 4; ++k_) { const int id_ = tid + 512 * k_, row_ = id_ >> 5, seg_ = id_ & 31;
            if (row_ < nvalid) {
                const u32x4 ov = *(const u32x4*)(OTl + row_ * 528 + seg_ * 16);
                const f32x4 ga = *(const f32x4*)(GNl + seg_ * 8), gb = *(const f32x4*)(GNl + seg_ * 8 + 4);
                const u32x4 gr = grv[k_]; u32x4 wv;
                wv.x = pk2(bflo(ov.x) * ga[0] * silu_f(bflo(gr.x)), bfhi(ov.x) * ga[1] * silu_f(bfhi(gr.x)));
                wv.y = pk2(bflo(ov.y) * ga[2] * silu_f(bflo(gr.y)), bfhi(ov.y) * ga[3] * silu_f(bfhi(gr.y)));
                wv.z = pk2(bflo(ov.z) * gb[0] * silu_f(bflo(gr.z)), bfhi(ov.z) * gb[1] * silu_f(bfhi(gr.z)));
                wv.w = pk2(bflo(ov.w) * gb[2] * silu_f(bflo(gr.w)), bfhi(ov.w) * gb[3] * silu_f(bfhi(gr.w)));
                *(u32x4*)(CAT + (size_t)(t0 + row_) * DM + h * 256 + seg_ * 8) = wv;
            }
        }
        BAR_LDS();
        if (ci + 1 < nchunks) { GLA_STORE(); }
        BAR_LDS();
    }
#undef GLA_LOAD
#undef GLA_STORE
    {
        float* sp = s_out + (size_t)(4 * g) * 256 + 32 * w + r16;
#pragma unroll
        for (int db = 0; db < 8; ++db) {
#pragma unroll
            for (int j = 0; j < 4; ++j) { sp[j * 256] = S[db][0][j]; sp[j * 256 + 16] = S[db][1][j]; }
            sp += 16 * 256; asm volatile("" : "+v"(sp));
        }
    }
}

template <int MODE>
__device__ __forceinline__ void attn_item(const Params& p, unsigned char* sm, int h, int tok0, int nrows, int kvt0, int ntiles, int nkeys, int qpos0, const int TIDX) {
    const int tid = TIDX, w = __builtin_amdgcn_readfirstlane(tid >> 6), lane = tid & 63, r16 = lane & 15, g = lane >> 4;
    constexpr int KS = MODE == 0 ? 2 : 4;
    const int c = MODE == 0 ? (w & 1) : 0, rg = MODE == 0 ? (w >> 1) : w, doff = 64 * c;
    const int qrow = 16 * rg + r16; const bool valid = qrow < nrows;
    float* BIAS = (float*)(sm + 71680); float* XCH = (float*)(sm + 72448);
    const bf16_t* qsrc = (const bf16_t*)(p.ws + (MODE == 0 ? WS_DQ : WS_MQ)) + (size_t)(tok0 + (valid ? qrow : 0)) * 512 + h * 128 + doff + 8 * g;
    bf16x8 Qf[KS];
#pragma unroll
    for (int ks = 0; ks < KS; ++ks) Qf[ks] = *(const bf16x8*)(qsrc + 32 * ks);
    BAR_LDS();
    if (MODE == 0 && tid < 192) {
        const int rel = tid - 128, n = rel < 0 ? -rel : rel;
        int bk = n < 8 ? n : min(8 + (31 - __clz((n * n) >> 6)), 15);
        if (rel > 0) bk += 16;
        BIAS[tid] = p.in[8][bk * 4 + h] * LOG2E;
    }
    const unsigned char* kvg = p.ws + WS_KV + (size_t)kvt0 * 32768;
    u32x4 pkk[2], pvv[2];
#define AT_LOAD(t) do { _Pragma("unroll") for (int k_ = 0; k_ < 2; ++k_) { const int id_ = tid + 512 * k_; pkk[k_] = *(const u32x4*)(kvg + (size_t)(t) * 32768 + id_ * 16); pvv[k_] = *(const u32x4*)(kvg + (size_t)(t) * 32768 + 16384 + id_ * 16); } } while (0)
#define AT_STORE(buf) do { unsigned char* b_ = sm + (buf) * 35840; _Pragma("unroll") for (int k_ = 0; k_ < 2; ++k_) { const int id_ = tid + 512 * k_; \
        *(u32x4*)(b_ + (id_ >> 4) * 272 + (id_ & 15) * 16) = pkk[k_]; *(u32x4*)(b_ + 17408 + (id_ >> 3) * 144 + (id_ & 7) * 16) = pvv[k_]; } } while (0)
    AT_LOAD(0); AT_STORE(0);
    BAR_LDS();
    const float SC = (MODE == 0 ? 0.125f : 0.08838834764831845f) * LOG2E;
    float m_run = -1e30f, l_run = 0.f;
    f32x4 O[8];
#pragma unroll
    for (int cb = 0; cb < 8; ++cb) O[cb] = (f32x4){0.f, 0.f, 0.f, 0.f};
    const int qpos = qpos0 + qrow;
    for (int t = 0; t < ntiles; ++t) {
        if (t + 1 < ntiles) AT_LOAD(t + 1);
        const unsigned char* Kb = sm + (t & 1) * 35840; const unsigned char* Vb = Kb + 17408;
        f32x4 s[4];
#pragma unroll
        for (int kb = 0; kb < 4; ++kb) {
            f32x4 acc = (f32x4){0.f, 0.f, 0.f, 0.f};
#pragma unroll
            for (int ks = 0; ks < KS; ++ks) {
                const bf16x8 A = *(const bf16x8*)(Kb + (16 * kb + r16) * 272 + (doff + 32 * ks + 8 * g) * 2);
                acc = MFMA16(A, Qf[ks], acc);
            }
            s[kb] = acc;
        }
        float mx = -1e30f;
        if ((MODE == 1 || (64 * t + 63 - qpos0 <= -128)) && 64 * (t + 1) <= nkeys) {
            const float bfar = MODE == 0 ? BIAS[0] : 0.f;
#pragma unroll
            for (int kb = 0; kb < 4; ++kb)
#pragma unroll
                for (int j = 0; j < 4; ++j) { const float v = s[kb][j] * SC + bfar; s[kb][j] = v; mx = fmaxf(mx, v); }
        } else {
#pragma unroll
            for (int kb = 0; kb < 4; ++kb)
#pragma unroll
                for (int j = 0; j < 4; ++j) {
                    const int kpos = 64 * t + 16 * kb + 4 * g + j;
                    float v = s[kb][j] * SC;
                    if (MODE == 0) { const int rel = kpos - qpos; v += BIAS[max(rel, -128) + 128]; }
                    if (kpos >= nkeys) v = -1e30f;
                    s[kb][j] = v; mx = fmaxf(mx, v);
                }
        }
        mx = fmaxf(mx, __shfl_xor(mx, 16)); mx = fmaxf(mx, __shfl_xor(mx, 32));
        const float mnew = fmaxf(m_run, mx), alpha = __builtin_amdgcn_exp2f(m_run - mnew); m_run = mnew;
        float psum = 0.f;
#pragma unroll
        for (int kb = 0; kb < 4; ++kb)
#pragma unroll
            for (int j = 0; j < 4; ++j) { const float pv_ = __builtin_amdgcn_exp2f(s[kb][j] - mnew); s[kb][j] = pv_; psum += pv_; }
        l_run = l_run * alpha + psum;
#pragma unroll
        for (int cb = 0; cb < 8; ++cb) O[cb] = O[cb] * alpha;
        bf16x8 Pf[2];
#pragma unroll
        for (int k2 = 0; k2 < 2; ++k2) { u32x4 tt; tt.x = pk2(s[2 * k2][0], s[2 * k2][1]); tt.y = pk2(s[2 * k2][2], s[2 * k2][3]); tt.z = pk2(s[2 * k2 + 1][0], s[2 * k2 + 1][1]); tt.w = pk2(s[2 * k2 + 1][2], s[2 * k2 + 1][3]);
            Pf[k2] = __builtin_bit_cast(bf16x8, tt); }
#pragma unroll
        for (int cb = 0; cb < 8; ++cb)
#pragma unroll
            for (int k2 = 0; k2 < 2; ++k2) {
                const u32x2 a0 = *(const u32x2*)(Vb + (16 * cb + r16) * 144 + (32 * k2 + 4 * g) * 2);
                const u32x2 a1 = *(const u32x2*)(Vb + (16 * cb + r16) * 144 + (32 * k2 + 16 + 4 * g) * 2);
                const bf16x8 A = __builtin_bit_cast(bf16x8, ((u32x4){a0.x, a0.y, a1.x, a1.y}));
                O[cb] = MFMA16(A, Pf[k2], O[cb]);
            }
        if (t + 1 < ntiles) AT_STORE((t + 1) & 1);
        BAR_LDS();
    }
#undef AT_LOAD
#undef AT_STORE
    l_run += __shfl_xor(l_run, 16); l_run += __shfl_xor(l_run, 32);
    const float inv = 1.0f / l_run;
    bf16_t* CAT = (bf16_t*)(p.ws + WS_ABUF);
    if (MODE == 1) {
        if (valid) {
#pragma unroll
            for (int cb = 0; cb < 8; ++cb) { u32x2 wv; wv.x = pk2(O[cb][0] * inv, O[cb][1] * inv); wv.y = pk2(O[cb][2] * inv, O[cb][3] * inv);
                *(u32x2*)(CAT + (size_t)(tok0 + qrow) * DM + 1536 + h * 128 + 16 * cb + 4 * g) = wv; }
        }
    } else {
        const float* L = p.in[19];
        const float d1 = wave_sum(L[lane] * L[64 + lane]), d2 = wave_sum(L[128 + lane] * L[192 + lane]);
        const float lam_init = 0.2f, lam = __expf(d1) - __expf(d2) + lam_init;
        if (c == 1) {
#pragma unroll
            for (int cb = 0; cb < 8; ++cb) *(f32x4*)(XCH + (rg * 16 + r16) * 132 + 16 * cb + 4 * g) = O[cb] * inv;
        }
        BAR_LDS();
        if (c == 0) {
            float ss = 0.f;
#pragma unroll
            for (int cb = 0; cb < 8; ++cb) { const f32x4 x1 = *(const f32x4*)(XCH + (rg * 16 + r16) * 132 + 16 * cb + 4 * g); O[cb] = O[cb] * inv - lam * x1;
                ss += O[cb][0] * O[cb][0] + O[cb][1] * O[cb][1] + O[cb][2] * O[cb][2] + O[cb][3] * O[cb][3]; }
            ss += __shfl_xor(ss, 16); ss += __shfl_xor(ss, 32);
            const float rs = rsqrtf(ss * (1.0f / 128) + EPS) * (1.0f - lam_init);
            if (valid) {
#pragma unroll
                for (int cb = 0; cb < 8; ++cb) { const f32x4 gg = *(const f32x4*)(p.in[20] + 16 * cb + 4 * g);
                    u32x2 wv; wv.x = pk2(O[cb][0] * rs * gg[0], O[cb][1] * rs * gg[1]); wv.y = pk2(O[cb][2] * rs * gg[2], O[cb][3] * rs * gg[3]);
                    *(u32x2*)(CAT + (size_t)(tok0 + qrow) * DM + 1024 + h * 128 + 16 * cb + 4 * g) = wv; }
            }
        }
    }
}

__device__ __forceinline__ void phase_mixer(const Params& p, unsigned char* sm, const int TIDX, const int BIDX, const int rep) {
    unsigned* ctr = (unsigned*)(p.ws + WS_CTL) + 64 * rep;
    int* sitem = (int*)(sm + LDS_BYTES - 16);
    for (;;) {
        __syncthreads();
        if (TIDX == 0) *sitem = (int)atomicAdd(ctr, 1u);
        __syncthreads();
        int it = __builtin_amdgcn_readfirstlane(*sitem);
        int tl = TIDX; asm volatile("" : "+v"(tl));
        if (it >= 1760 + 258) break;
        if (it >= 1760) { if (rep == 0) { int tl2 = TIDX; asm volatile("" : "+v"(tl2)); conv_item(p, sm, 1, it - 1760, tl2); } continue; }
        int kind, h, a0, a1, a2, a3, a4, a5; const float* sin = nullptr; float* sout = nullptr;
        if (it < 32) { const int b = it >> 2; h = it & 3; kind = 0; a0 = (b * 32) * 4 + h; a1 = 32; a2 = b * 2048; a3 = 64; a4 = 0; a5 = 0; sout = p.out + O_GSP + (size_t)(b * 4 + h) * 32768; }
        else if (it < 544 || (it >= 608 && it < 1120)) { it -= (it < 544 ? 32 : 96); const int qc = 31 - (it >> 5), bh = it & 31, b = bh >> 2; h = bh & 3; kind = 1;
            a0 = b * 2048 + qc * 64; a1 = 64; a2 = (b * 4 + h) * 32; a3 = qc + 1; a4 = (qc + 1) * 64; a5 = qc * 64; }
        else if (it < 608) { it -= 544; const int sb = it >> 2; h = it & 3; kind = 1; a0 = TP + sb * 32; a1 = 32; a2 = 1024 + (sb * 4 + h) * 17; a3 = 17; a4 = 1056; a5 = 1024; }
        else if (it < 1184) { it -= 1120; const int sb = it >> 2; h = it & 3; kind = 0; a0 = (256 + sb) * 4 + h; a1 = 1; a2 = TP + sb * 32; a3 = 32; a4 = 0; a5 = 0;
            sin = p.in[5] + (size_t)(sb * 4 + h) * 32768; sout = p.out + O_GSS + (size_t)(sb * 4 + h) * 32768; }
        else if (it < 1696) { it -= 1184; const int qb = it & 15, bh = it >> 4, b = bh >> 2; h = bh & 3; kind = 2; a0 = b * 2048 + qb * 128; a1 = 128; a2 = 2112 + (b * 4 + h) * 4; a3 = 4; a4 = 256; a5 = 0; }
        else { it -= 1696; const int sb = it >> 2; h = it & 3; kind = 2; a0 = TP + sb * 32; a1 = 32; a2 = 2240 + (sb * 4 + h) * 4; a3 = 4; a4 = 256; a5 = 0; }
#ifndef MIXSEL
#define MIXSEL 7
#endif
#ifndef REPSEL
#define REPSEL 3
#endif
        if (rep == 1) { const bool isgp = (kind == 0 && a1 == 32); if (isgp && !(REPSEL & 1)) continue; if (!isgp && !(REPSEL & 2)) continue; }
        if (kind == 0) { if (MIXSEL & 1) gla_item(p, sm, h, a0, 4, a1, a2, a3, sin, sout, tl); }
        else if (kind == 1) { if (MIXSEL & 2) attn_item<0>(p, sm, h, a0, a1, a2, a3, a4, a5, tl); }
        else { if (MIXSEL & 4) attn_item<1>(p, sm, h, a0, a1, a2, a3, a4, a5, tl); }
    }
}

#define XB_TMO      128
#define XB_XCNT(j)  (256  + 64 * (j))
#define XB_XSUB(j)  (1280 + 64 * (j))
#define XB_XGEN(j)  (2304 + 64 * (j))
#define XB_TOP      3328
#define XB_TOPGEN   3392
#define XCD_BAR_WORDS 3456
#define XB_SPIN_CAP (1u << 22)
__device__ __forceinline__ unsigned xb_ld(unsigned* p)              { return __hip_atomic_load(p, __ATOMIC_RELAXED, __HIP_MEMORY_SCOPE_AGENT); }
__device__ __forceinline__ unsigned xb_add(unsigned* p, unsigned v) { return __hip_atomic_fetch_add(p, v, __ATOMIC_RELAXED, __HIP_MEMORY_SCOPE_AGENT); }
__device__ __forceinline__ unsigned xb_xcc_id() { return (unsigned)__builtin_amdgcn_s_getreg((3 << 11) | 20) & 0xFu; }
#define XB_SPIN(cond, bar) do { unsigned _sp = 0; while (cond) { __builtin_amdgcn_s_sleep(1); \
    if ((++_sp & 255u) == 0u) { if (xb_ld(&(bar)[XB_TMO])) break; if (_sp > XB_SPIN_CAP) { atomicAdd(&(bar)[XB_TMO], 1u); break; } } } } while (0)
__device__ __forceinline__ void xcd_barrier_complete(unsigned* bar, unsigned x, unsigned& nloc, unsigned& nx) {
    const unsigned G = gridDim.x * gridDim.y * gridDim.z;
    unsigned sum, cnt, mine, sp = 0u;
    for (;;) {
        sum = 0u; cnt = 0u; mine = 0u;
#pragma unroll
        for (unsigned j = 0; j < 16; ++j) { const unsigned c = xb_ld(&bar[XB_XCNT(j)]); sum += c; cnt += (c > 0u) ? 1u : 0u; mine = (j == x) ? c : mine; }
        if (sum == G) break;
        __builtin_amdgcn_s_sleep(1);
        if ((++sp & 255u) == 0u) { if (xb_ld(&bar[XB_TMO])) break; if (sp > XB_SPIN_CAP) { atomicAdd(&bar[XB_TMO], 1u); break; } }
    }
    nloc = mine > 0u ? mine : 1u; nx = cnt > 0u ? cnt : 1u;
}
__device__ __forceinline__ void xcd_barrier(unsigned* bar, volatile LAS unsigned* st, const int TIDX) {
    asm volatile("s_waitcnt vmcnt(0)" ::: "memory");
    __syncthreads();
    if (TIDX == 0) {
        const unsigned x = xb_xcc_id();
        __builtin_amdgcn_s_waitcnt(0);
        unsigned nloc = st[0], nx = st[1];
        if (nloc == 0u) { xcd_barrier_complete(bar, x, nloc, nx); st[0] = nloc; st[1] = nx; }
        const unsigned old = xb_add(&bar[XB_XSUB(x)], 1u);
        const unsigned gen = old / nloc;
        if (old + 1u == (gen + 1u) * nloc) {
            __builtin_amdgcn_fence(__ATOMIC_RELEASE, "agent");
            asm volatile("s_waitcnt vmcnt(0)" ::: "memory");
            const unsigned og = xb_add(&bar[XB_TOP], 1u);
            const unsigned tg = og / nx;
            if (og + 1u == (tg + 1u) * nx) xb_add(&bar[XB_TOPGEN], 1u);
            else XB_SPIN(xb_ld(&bar[XB_TOPGEN]) == tg, bar);
            __builtin_amdgcn_fence(__ATOMIC_ACQUIRE, "agent");
            xb_add(&bar[XB_XGEN(x)], 1u);
            asm volatile("s_waitcnt vmcnt(0)" ::: "memory");
        } else {
            XB_SPIN(xb_ld(&bar[XB_XGEN(x)]) == gen, bar);
            __builtin_amdgcn_fence(__ATOMIC_ACQUIRE, "agent");
            asm volatile("s_waitcnt vmcnt(0)" ::: "memory");
        }
    }
    __syncthreads();
}

struct KArgs { Params p; int ph_lo, ph_hi, rep_ph, pad_; };
__global__ __launch_bounds__(512, 2) void mega(Params p_unused, int ph_lo_unused, int ph_hi_unused, int rep_unused, int pad_unused) {
    extern __shared__ __attribute__((aligned(16))) unsigned char shm[];
    typedef const KArgs __attribute__((address_space(4))) * kargp_t;
    kargp_t ka0 = (kargp_t)__builtin_amdgcn_kernarg_segment_ptr();
    const int ph_lo = ka0->ph_lo, ph_hi = ka0->ph_hi, rep_ph = ka0->rep_ph;
    volatile LAS unsigned* xst = (volatile LAS unsigned*)(LAS unsigned char*)(shm + LDS_BYTES - 32);
    const int wave_s = __builtin_amdgcn_readfirstlane((int)threadIdx.x >> 6);
    if (threadIdx.x == 0) { xst[0] = 0u; xst[1] = 0u; (void)xb_add(&((unsigned*)(ka0->p.ws + WS_CTL))[XB_XCNT(xb_xcc_id())], 1u); }
    __syncthreads();
    for (int ph = ph_lo; ph < ph_hi; ++ph)
    for (int rep = 0; rep < ((ph == rep_ph) ? 2 : 1); ++rep) {
        kargp_t ka = ka0; asm volatile("" : "+s"(ka));
        int wv_ = wave_s; asm volatile("" : "+s"(wv_));
        int TIDX = (wv_ << 6) | (int)__builtin_amdgcn_mbcnt_hi(~0u, __builtin_amdgcn_mbcnt_lo(~0u, 0u)), BIDX = blockIdx.x; asm volatile("" : "+v"(TIDX)); asm volatile("" : "+s"(BIDX));
        Params p;
#pragma unroll
        for (int i = 0; i < 30; ++i) p.in[i] = ka->p.in[i];
        p.out = ka->p.out; p.ws = ka->p.ws;
        const bool is_gemm = (ph == 1 || ph == 2 || ph == 4 || ph == 7 || ph == 9 || ph == 10);
#ifndef PHSEL
#define PHSEL 0xfff
#endif
        if (is_gemm && (PHSEL & 2)) {
            pg8::Sched S; float alpha = 1.f;
            S.G = gridDim.x; S.c = BIDX; S.K = DM; S.split = 0;
            S.g1.A = nullptr; S.g1.Bt = nullptr; S.g1.nM = 1; S.g1.nN = 1; S.g1.mode = 0;
            const bf16_t* ABUF = (const bf16_t*)(p.ws + WS_ABUF); const bf16_t* Hb = (const bf16_t*)(p.ws + WS_H);
            if (ph == 1 || ph == 9) { S.g0.A = ABUF; S.g0.Bt = (const bf16_t*)(p.ws + (ph == 1 ? WS_WFI : WS_WFI2)); S.g0.nM = 66; S.g0.nN = 43; S.g0.mode = pg8::EPI_SWIGLU; }
            else if (ph == 2 || ph == 10) { S.g0.A = Hb; S.g0.Bt = (const bf16_t*)(p.ws + (ph == 2 ? WS_WFO : WS_WFO2)); S.g0.nM = 66; S.g0.nN = 8; S.g0.mode = ph == 2 ? pg8::EPI_RESX : pg8::EPI_RESIN; S.K = DFF; alpha = 0.5f; }
            else if (ph == 4) { S.g0.A = ABUF; S.g0.Bt = (const bf16_t*)(p.ws + WS_WIN); S.g0.nM = 66; S.g0.nN = 22; S.g0.mode = pg8::EPI_WIN; }
            else { S.g0.A = ABUF; S.g0.Bt = (const bf16_t*)(p.ws + WS_WO); S.g0.nM = 66; S.g0.nN = 8; S.g0.mode = pg8::EPI_RESIN; alpha = 1.f; }
            S.n0 = S.g0.nM * S.g0.nN; S.ntot = S.n0;
            if (ph == 2 || ph == 7 || ph == 10) { S.split = 1; S.g0.nM = 64; S.n0 = 512; S.ntot = 640; }
            if (ph == 1) { S.g1.A = (const bf16_t*)(p.ws + WS_AMEM); S.g1.Bt = (const bf16_t*)(p.ws + WS_WMEM); S.g1.nM = 8; S.g1.nN = 4; S.g1.mode = pg8::EPI_MEMKV; S.ntot = S.n0 + 32; }
            pg8::gemm_phase((LAS unsigned char*)shm, p, S, alpha, TIDX);
            if (ph == 1 && rep == 0) conv_queue(p, shm, 0, 206, (unsigned*)(p.ws + WS_CTL) + 8, TIDX);
        } else if (ph == 0 && (PHSEL & 1)) phase_prep0(p, shm, TIDX, BIDX);
        else if (ph == 3 && (PHSEL & 8)) phase_norm(p, shm, 0, TIDX, BIDX);
        else if (ph == 5 && (PHSEL & 32)) phase_post(p, shm, TIDX, BIDX);
        else if (ph == 6 && (PHSEL & 64)) phase_mixer(p, shm, TIDX, BIDX, rep);
        else if (ph == 8 && (PHSEL & 8)) phase_norm(p, shm, 1, TIDX, BIDX);
        else if (ph == 11 && (PHSEL & 8)) phase_norm(p, shm, 2, TIDX, BIDX);
        if (ph + 1 < ph_hi) { if (ph_hi < 0) cg::this_grid().sync(); else xcd_barrier((unsigned*)(p.ws + WS_CTL), xst, TIDX); }
    }
}

extern "C" void kernel_launch(void* const* d_in, const int* in_sizes, int n_in, void* d_out, int out_size, void* d_ws, size_t ws_size, hipStream_t stream) {
    static int grid = 0;
    if (grid == 0) {
        if (n_in != 30 || ws_size < WS_END) { fprintf(stderr, "kernel_launch: need 30 inputs and >= %zu bytes of workspace; got n_in %d ws %zu\n", (size_t)WS_END, n_in, ws_size); grid = -1; return; }
        if (hipFuncSetAttribute((const void*)mega, hipFuncAttributeMaxDynamicSharedMemorySize, LDS_BYTES) != hipSuccess) { fprintf(stderr, "kernel_launch: hipFuncSetAttribute failed\n"); grid = -1; return; }
        int dev = 0, cus = 0, per_cu = 0;
        (void)hipGetDevice(&dev); (void)hipDeviceGetAttribute(&cus, hipDeviceAttributeMultiprocessorCount, dev);
        (void)hipOccupancyMaxActiveBlocksPerMultiprocessor(&per_cu, (const void*)mega, 512, LDS_BYTES);
        if (per_cu < 1) { fprintf(stderr, "kernel_launch: occupancy query says %d blocks per CU\n", per_cu); per_cu = 1; }
        (void)hipGetLastError();
        grid = cus;
    }
    if (grid < 0) return;
    Params p{};
    for (int i = 0; i < 30; ++i) p.in[i] = (const float*)d_in[i];
    p.out = (float*)d_out; p.ws = (unsigned char*)d_ws;
    if (hipMemsetAsync((char*)d_ws + WS_CTL, 0, 16384, stream) != hipSuccess) { fprintf(stderr, "kernel_launch: memset of control words failed\n"); return; }
#if MK_MULTI
    for (int ph = 0; ph < 12; ++ph) { hipLaunchKernelGGL(mega, dim3(grid), dim3(512), LDS_BYTES, stream, p, ph, ph + 1, -1, 0); }
#else
    int lo = 0, hi = 12, rp = REP_PH, pd = 0;
    void* args[] = {(void*)&p, (void*)&lo, (void*)&hi, (void*)&rp, (void*)&pd};
    hipError_t e = hipLaunchCooperativeKernel((const void*)mega, dim3(grid), dim3(512), args, LDS_BYTES, stream);
    if (e != hipSuccess) fprintf(stderr, "cooperative launch failed: %s (grid %d)\n", hipGetErrorString(e), grid);
#endif
}
```
